# Optimizing an MI355X kernel written in HIP

```python
import jax, jax.numpy as jnp
from jax import lax
import numpy as np

D_MODEL = 1024
BATCH = 4
SEQ = 4096
DEPTH = 1
DEC_BATCH = 128
DEC_SEQ = 8
PAST_LEN = 2048
PAGE_SIZE = 128

RWKV_HEADS = 8
RWKV_HEAD = 64
RWKV_W = RWKV_HEADS * RWKV_HEAD
DECAY_RANK = 64
AAA_RANK = 64
GATE_RANK = 160
RWKV_GN_EPS = 64e-5

NSA_HEADS = 8
NSA_KV = 2
HEAD_DIM = 64
HPG = NSA_HEADS // NSA_KV
NSA_W = NSA_HEADS * HEAD_DIM
KV_W = NSA_KV * HEAD_DIM
L_CMP = 32
D_CMP = 16
CMP_HID = 128
L_SEL = 64
N_SEL = 16
WINDOW = 512
Q_BLK = 128
ROT_DIM = HEAD_DIM // 4
ROPE_THETA = 500000.0

D_FF = -(-8 * D_MODEL // (3 * 256)) * 256
NORM_EPS = 1e-6
NEG = -1e30
FORCE = 1e6

RWKV_COLS = 3 * RWKV_W + DECAY_RANK + AAA_RANK + GATE_RANK
NSA_COLS = NSA_W + 6 * KV_W + 3 * NSA_HEADS
IN_COLS = RWKV_COLS + NSA_COLS + 2 * D_MODEL
RWKV_SPLITS = (RWKV_W, RWKV_W + DECAY_RANK, 2 * RWKV_W + DECAY_RANK, 3 * RWKV_W + DECAY_RANK, 3 * RWKV_W + DECAY_RANK + AAA_RANK)
NSA_SPLITS = tuple(NSA_W + i * KV_W for i in range(7))
IN_SPLITS = (RWKV_COLS, RWKV_COLS + NSA_COLS, RWKV_COLS + NSA_COLS + D_MODEL)

kernel_name = 'rwkv7_nsa_gated_hybrid_step'


def rms_norm(x, g):
    xf = x.astype(jnp.float32)
    y = xf * lax.rsqrt(jnp.mean(xf * xf, axis=-1, keepdims=True) + NORM_EPS)
    return (y * g.astype(jnp.float32)).astype(x.dtype)


def partial_rope(x, pos):
    half = ROT_DIM // 2
    inv = ROPE_THETA ** (-jnp.arange(half, dtype=jnp.float32) / half)
    ang = pos.astype(jnp.float32)[:, None] * inv[None, :]
    cos = jnp.cos(ang)[None, :, None, :]
    sin = jnp.sin(ang)[None, :, None, :]
    xf = x.astype(jnp.float32)
    x1, x2 = xf[..., :half], xf[..., half:ROT_DIM]
    out = jnp.concatenate([x1 * cos - x2 * sin, x2 * cos + x1 * sin, xf[..., ROT_DIM:]], axis=-1)
    return out.astype(x.dtype)


def masked_softmax(s, mask):
    p = jax.nn.softmax(jnp.where(mask, s.astype(jnp.float32), NEG), axis=-1)
    return jnp.where(mask, p, 0.0)


def rwkv7_scan(S0, r, decay, k, v, a_vec, b_vec):
    def step(S, inp):
        r_t, w_t, k_t, v_t, a_t, b_t = inp
        sa = jnp.einsum('bhij,bhj->bhi', S, a_t)
        S = S * w_t[:, :, None, :] + sa[..., None] * b_t[:, :, None, :] + v_t[..., None] * k_t[:, :, None, :]
        return S, jnp.einsum('bhij,bhj->bhi', S, r_t)
    xs = tuple(jnp.moveaxis(z, 1, 0) for z in (r, decay, k, v, a_vec, b_vec))
    S, y = lax.scan(step, S0, xs)
    return jnp.moveaxis(y, 0, 1), S


def rwkv7_time_mix(p, prev_row, S0, lp):
    B, T, _ = p.shape
    f32 = jnp.float32
    shifted = jnp.concatenate([prev_row[:, None, :].astype(p.dtype), p[:, :-1]], axis=1)
    xs = p + (shifted - p) * lp['mu']
    r, wlo, k, v, alo, glo = jnp.split(xs, RWKV_SPLITS, axis=-1)
    w = -jax.nn.softplus(-(lp['w0'] + jnp.tanh(wlo) @ lp['w_decay'])) - 0.5
    decay = jnp.exp(-jnp.exp(w.astype(f32)))
    a = jax.nn.sigmoid(lp['a0'] + alo @ lp['w_aaa'])
    g = jax.nn.sigmoid(glo) @ lp['w_gate']
    hd = lambda z: z.astype(f32).reshape(B, T, RWKV_HEADS, RWKV_HEAD)
    kk = hd(k * lp['k_k'])
    kk = kk * lax.rsqrt(jnp.maximum(jnp.sum(kk * kk, axis=-1, keepdims=True), 1e-24))
    k_h = hd(k * (1 + (a - 1) * lp['k_a']))
    r_h, v_h, a_h = hd(r), hd(v), hd(a)
    y, S = rwkv7_scan(S0.astype(f32), r_h, hd(decay), k_h, v_h, -kk, kk * a_h)
    mean = jnp.mean(y, axis=-1, keepdims=True)
    var = jnp.mean(jnp.square(y - mean), axis=-1, keepdims=True)
    y = ((y - mean) * lax.rsqrt(var + RWKV_GN_EPS)).reshape(B, T, RWKV_W) * lp['ln_w'] + lp['ln_b']
    bonus = jnp.sum(r_h * k_h * lp['r_k'], axis=-1, keepdims=True) * v_h
    out = (y + bonus.reshape(B, T, RWKV_W)) * g
    return out.astype(p.dtype), p[:, -1], S


def compress_blocks(kv, pe, w1, w2):
    B, T = kv.shape[:2]
    n_chunk = T // D_CMP
    ch = kv[:, :n_chunk * D_CMP].reshape(B, n_chunk, D_CMP, 2, NSA_KV, HEAD_DIM)
    pe_t = jnp.swapaxes(pe, 0, 1)[:, :, None, :]
    h_first = jnp.einsum('bnlcgd,cldh->bncgh', ch + pe_t[:D_CMP], w1[:, :D_CMP])
    h_second = jnp.einsum('bnlcgd,cldh->bncgh', ch + pe_t[D_CMP:], w1[:, D_CMP:])
    h = jax.nn.silu(h_first[:, :-1] + h_second[:, 1:])
    out = jnp.einsum('bncgh,chd->bncgd', h, w2)
    return out[:, :, 0], out[:, :, 1]


def nsa_compress_select(q, pos, kv_cmp, lp):
    B, tq = q.shape[:2]
    T_all = kv_cmp.shape[1]
    kc, vc = compress_blocks(kv_cmp, lp['nsa_pe_cmp'], lp['nsa_w_cmp1'], lp['nsa_w_cmp2'])
    n_c = kc.shape[1]
    n_s = -(-T_all // L_SEL)
    qg = q.reshape(B, tq, NSA_KV, HPG, HEAD_DIM)
    s = jnp.einsum('btghd,bngd->bghtn', qg, kc) * HEAD_DIM ** -0.5
    ends = jnp.arange(n_c) * D_CMP + (L_CMP - 1)
    p = masked_softmax(s, ends[None, :] <= pos[:, None])
    o_c = jnp.einsum('bghtn,bngd->btghd', p, vc.astype(jnp.float32)).reshape(B, tq, NSA_HEADS, HEAD_DIM)
    ci = np.arange(n_c)[:, None]
    sj = np.arange(n_s)[None, :]
    overlap = jnp.asarray(((ci * D_CMP < (sj + 1) * L_SEL) & (ci * D_CMP + L_CMP > sj * L_SEL)).astype(np.float32))
    imp = jnp.einsum('bghtn,ns->bgts', p, overlap)
    cur = (pos // L_SEL)[None, None, :, None]
    j = jnp.arange(n_s)[None, None, None, :]
    score = jnp.where((j == 0) | (j == cur) | (j == cur - 1), FORCE, jnp.where(j <= cur, imp, -1.0))
    _, idx = lax.top_k(score, min(N_SEL, n_s))
    valid = idx <= cur
    return o_c, idx, valid, n_s


def selection_blocks(kv, n_s):
    B, T = kv.shape[:2]
    kv = jnp.pad(kv, ((0, 0), (0, n_s * L_SEL - T), (0, 0), (0, 0), (0, 0)))
    kv = kv.reshape(B, n_s, L_SEL, 2, NSA_KV, HEAD_DIM).transpose(3, 0, 4, 1, 2, 5)
    return kv[0], kv[1]


def selection_attn(q, pos, idx, valid, kb, vb):
    B, tq = q.shape[:2]
    qg = q.reshape(B, tq, NSA_KV, HPG, HEAD_DIM)
    bi = jnp.arange(B)[:, None, None, None]
    gi = jnp.arange(NSA_KV)[None, :, None, None]
    kg = kb[bi, gi, idx]
    vg = vb[bi, gi, idx]
    n_k = idx.shape[-1]
    s = jnp.einsum('btghd,bgtnld->bghtnl', qg, kg) * HEAD_DIM ** -0.5
    tok = idx[..., None] * L_SEL + jnp.arange(L_SEL)
    mask = (valid[..., None] & (tok <= pos[None, None, :, None, None]))[:, :, None]
    p = masked_softmax(s.reshape(B, NSA_KV, HPG, tq, n_k * L_SEL), mask.reshape(B, NSA_KV, 1, tq, n_k * L_SEL))
    o = jnp.einsum('bghtm,bgtmd->btghd', p, vg.reshape(B, NSA_KV, tq, n_k * L_SEL, HEAD_DIM).astype(jnp.float32))
    return o.reshape(B, tq, NSA_HEADS, HEAD_DIM)


def window_attn(q, pos, kv, kpos):
    B, tq = q.shape[:2]
    qg = q.reshape(B, tq, NSA_KV, HPG, HEAD_DIM)
    s = jnp.einsum('btghd,bsgd->bghts', qg, kv[:, :, 0]) * HEAD_DIM ** -0.5
    mask = (kpos[None, :] <= pos[:, None]) & (kpos[None, :] > pos[:, None] - WINDOW) & (kpos[None, :] >= 0)
    p = masked_softmax(s, mask)
    o = jnp.einsum('bghts,bsgd->btghd', p, kv[:, :, 1].astype(jnp.float32))
    return o.reshape(B, tq, NSA_HEADS, HEAD_DIM)


def nsa_prompt(q, pos, kv_cmp, kv_slc, kv_win, lp):
    B, T = q.shape[:2]
    o_c, idx, valid, n_s = nsa_compress_select(q, pos, kv_cmp, lp)
    q_r = partial_rope(q, pos)
    kb, vb = selection_blocks(kv_slc, n_s)
    kw = jnp.pad(kv_win, ((0, 0), (WINDOW, 0), (0, 0), (0, 0), (0, 0)))

    def query_block(nb):
        start = nb * Q_BLK
        qb = lax.dynamic_slice_in_dim(q_r, start, Q_BLK, axis=1)
        pb = start + jnp.arange(Q_BLK)
        o_s = selection_attn(qb, pb, lax.dynamic_slice_in_dim(idx, start, Q_BLK, axis=2),
                             lax.dynamic_slice_in_dim(valid, start, Q_BLK, axis=2), kb, vb)
        kwb = lax.dynamic_slice_in_dim(kw, start, WINDOW + Q_BLK, axis=1)
        o_w = window_attn(qb, pb, kwb, start - WINDOW + jnp.arange(WINDOW + Q_BLK))
        return o_s, o_w

    o_s, o_w = lax.map(query_block, jnp.arange(T // Q_BLK))
    unblock = lambda o: jnp.moveaxis(o, 0, 1).reshape(B, T, NSA_HEADS, HEAD_DIM)
    return o_c, unblock(o_s), unblock(o_w)


def nsa_sample(q, pos, kv_cmp, kv_slc, kv_win, win_pos, lp):
    o_c, idx, valid, n_s = nsa_compress_select(q, pos, kv_cmp, lp)
    q_r = partial_rope(q, pos)
    kb, vb = selection_blocks(kv_slc, n_s)
    return o_c, selection_attn(q_r, pos, idx, valid, kb, vb), window_attn(q_r, pos, kv_win, win_pos)


def gather_pages(cache, page_table):
    g = cache[page_table]
    return g.reshape(page_table.shape[0], -1, *cache.shape[2:])


def trunk_layer(x, pos, lp, S0, shift0, past):
    B, T, _ = x.shape
    h = rms_norm(x, lp['g_mix'])
    proj = h @ lp['w_in']
    p_rwkv, p_nsa, gate_r, gate_n = jnp.split(proj, IN_SPLITS, axis=-1)
    y_r, shift_new, S_new = rwkv7_time_mix(p_rwkv, shift0, S0, lp)
    q, kc, vc, ks, vs, kw, vw, g_nsa = jnp.split(p_nsa, NSA_SPLITS, axis=-1)
    q = q.reshape(B, T, NSA_HEADS, HEAD_DIM)
    kvh = lambda z: z.reshape(B, T, NSA_KV, HEAD_DIM)
    new_cmp = jnp.stack([kvh(kc), kvh(vc)], axis=2)
    new_slc = jnp.stack([partial_rope(kvh(ks), pos), kvh(vs)], axis=2)
    new_win = jnp.stack([partial_rope(kvh(kw), pos), kvh(vw)], axis=2)
    if past is None:
        o_c, o_s, o_w = nsa_prompt(q, pos, new_cmp, new_slc, new_win, lp)
        win_state = new_win[:, T - min(WINDOW, T):]
    else:
        cmp_past, slc_past, win_buf, buf_pos = past
        win_all = jnp.concatenate([win_buf.astype(new_win.dtype), new_win], axis=1)
        win_pos = jnp.concatenate([buf_pos, pos])
        o_c, o_s, o_w = nsa_sample(q, pos, jnp.concatenate([cmp_past.astype(new_cmp.dtype), new_cmp], axis=1),
                                   jnp.concatenate([slc_past.astype(new_slc.dtype), new_slc], axis=1),
                                   win_all, win_pos, lp)
        n_all = win_all.shape[1]
        win_state = win_all[:, n_all - min(WINDOW, n_all):]
    gts = jax.nn.sigmoid(g_nsa.astype(jnp.float32)).reshape(B, T, NSA_HEADS, 3)
    o = gts[..., 0:1] * o_c + gts[..., 1:2] * o_s + gts[..., 2:3] * o_w
    y_n = o.reshape(B, T, NSA_W).astype(x.dtype)
    merged = jax.nn.sigmoid(gate_r) * (y_r @ lp['w_br_rwkv']) + jax.nn.sigmoid(gate_n) * (y_n @ lp['w_br_nsa'])
    x = x + merged @ lp['w_out']
    h2 = rms_norm(x, lp['g_ffn'])
    x = x + (jax.nn.silu(h2 @ lp['w_ffn_gate']) * (h2 @ lp['w_ffn_up'])) @ lp['w_ffn_down']
    return x, (new_cmp, new_slc, win_state, S_new, shift_new)


def setup_inputs(seed: int = 0) -> dict:
    key = jax.random.key(seed)
    keys = jax.random.split(key, 40)
    ks = iter([keys[i] for i in range(40)])
    nrm = lambda shape, scale: scale * jax.random.normal(next(ks), shape, jnp.float32)
    uni = lambda shape, lo, hi: jax.random.uniform(next(ks), shape, jnp.float32, lo, hi)
    n_pages = PAST_LEN // PAGE_SIZE
    n_used = DEC_BATCH * n_pages
    n_pool = n_used + (n_used + 3) // 4
    w_buf = min(WINDOW, PAST_LEN)
    out = {}
    out['x_prompt'] = nrm((BATCH, SEQ, D_MODEL), 1.0)
    out['x_sample'] = nrm((DEC_BATCH, DEC_SEQ, D_MODEL), 1.0)
    out['cache_cmp_kv'] = nrm((DEPTH, n_pool, PAGE_SIZE, 2, NSA_KV, HEAD_DIM), 1.0)
    out['cache_slc_kv'] = nrm((DEPTH, n_pool, PAGE_SIZE, 2, NSA_KV, HEAD_DIM), 1.0)
    out['cache_win_kv'] = nrm((DEPTH, DEC_BATCH, w_buf, 2, NSA_KV, HEAD_DIM), 1.0)
    out['state_rwkv'] = nrm((DEPTH, DEC_BATCH, RWKV_HEADS, RWKV_HEAD, RWKV_HEAD), 0.5)
    out['state_rwkv_shift'] = nrm((DEPTH, DEC_BATCH, RWKV_COLS), 1.0)
    perm = jax.random.permutation(next(ks), n_pool)
    out['page_table'] = perm[:n_used].reshape(DEC_BATCH, n_pages).astype(jnp.int32)
    out['g_mix'] = 1.0 + nrm((DEPTH, D_MODEL), 0.02)
    out['w_in'] = nrm((DEPTH, D_MODEL, IN_COLS), D_MODEL ** -0.5)
    out['rwkv_mu'] = uni((DEPTH, RWKV_COLS), 0.0, 1.0)
    out['rwkv_w0'] = uni((DEPTH, RWKV_W), -5.0, -0.5)
    out['rwkv_w_decay'] = nrm((DEPTH, DECAY_RANK, RWKV_W), 0.5 * DECAY_RANK ** -0.5)
    out['rwkv_a0'] = nrm((DEPTH, RWKV_W), 0.5)
    out['rwkv_w_aaa'] = nrm((DEPTH, AAA_RANK, RWKV_W), AAA_RANK ** -0.5)
    out['rwkv_w_gate'] = nrm((DEPTH, GATE_RANK, RWKV_W), GATE_RANK ** -0.5)
    out['rwkv_k_k'] = 0.85 + nrm((DEPTH, RWKV_W), 0.05)
    out['rwkv_k_a'] = 1.0 + nrm((DEPTH, RWKV_W), 0.05)
    out['rwkv_r_k'] = nrm((DEPTH, RWKV_HEADS, RWKV_HEAD), 0.1)
    out['rwkv_ln_w'] = 1.0 + nrm((DEPTH, RWKV_W), 0.02)
    out['rwkv_ln_b'] = nrm((DEPTH, RWKV_W), 0.01)
    out['nsa_pe_cmp'] = nrm((DEPTH, 2, L_CMP, HEAD_DIM), 0.1)
    out['nsa_w_cmp1'] = nrm((DEPTH, 2, L_CMP, HEAD_DIM, CMP_HID), (L_CMP * HEAD_DIM) ** -0.5)
    out['nsa_w_cmp2'] = nrm((DEPTH, 2, CMP_HID, HEAD_DIM), CMP_HID ** -0.5)
    out['w_br_rwkv'] = nrm((DEPTH, RWKV_W, D_MODEL), RWKV_W ** -0.5)
    out['w_br_nsa'] = nrm((DEPTH, NSA_W, D_MODEL), NSA_W ** -0.5)
    out['w_out'] = nrm((DEPTH, D_MODEL, D_MODEL), D_MODEL ** -0.5)
    out['g_ffn'] = 1.0 + nrm((DEPTH, D_MODEL), 0.02)
    out['w_ffn_gate'] = nrm((DEPTH, D_MODEL, D_FF), D_MODEL ** -0.5)
    out['w_ffn_up'] = nrm((DEPTH, D_MODEL, D_FF), D_MODEL ** -0.5)
    out['w_ffn_down'] = nrm((DEPTH, D_FF, D_MODEL), D_FF ** -0.5)
    out['g_final'] = 1.0 + nrm((D_MODEL,), 0.02)
    return out


def reference(x_prompt, x_sample, cache_cmp_kv, cache_slc_kv, cache_win_kv, state_rwkv, state_rwkv_shift,
              page_table, g_mix, w_in, rwkv_mu, rwkv_w0, rwkv_w_decay, rwkv_a0, rwkv_w_aaa, rwkv_w_gate,
              rwkv_k_k, rwkv_k_a, rwkv_r_k, rwkv_ln_w, rwkv_ln_b, nsa_pe_cmp, nsa_w_cmp1, nsa_w_cmp2,
              w_br_rwkv, w_br_nsa, w_out, g_ffn, w_ffn_gate, w_ffn_up, w_ffn_down, g_final):
    B, T = x_prompt.shape[:2]
    TS = x_sample.shape[1]
    past_len = page_table.shape[1] * cache_cmp_kv.shape[2]
    pos_p = jnp.arange(T)
    pos_s = past_len + jnp.arange(TS)
    w_buf = cache_win_kv.shape[2]
    buf_pos = past_len - w_buf + jnp.arange(w_buf)
    xp, xs = x_prompt, x_sample
    outs_p, outs_s = [], []
    for l in range(DEPTH):
        lp = {'g_mix': g_mix[l], 'w_in': w_in[l], 'mu': rwkv_mu[l], 'w0': rwkv_w0[l],
              'w_decay': rwkv_w_decay[l], 'a0': rwkv_a0[l], 'w_aaa': rwkv_w_aaa[l], 'w_gate': rwkv_w_gate[l],
              'k_k': rwkv_k_k[l], 'k_a': rwkv_k_a[l], 'r_k': rwkv_r_k[l], 'ln_w': rwkv_ln_w[l], 'ln_b': rwkv_ln_b[l],
              'nsa_pe_cmp': nsa_pe_cmp[l], 'nsa_w_cmp1': nsa_w_cmp1[l], 'nsa_w_cmp2': nsa_w_cmp2[l],
              'w_br_rwkv': w_br_rwkv[l], 'w_br_nsa': w_br_nsa[l], 'w_out': w_out[l], 'g_ffn': g_ffn[l],
              'w_ffn_gate': w_ffn_gate[l], 'w_ffn_up': w_ffn_up[l], 'w_ffn_down': w_ffn_down[l]}
        xp, st_p = trunk_layer(xp, pos_p, lp, jnp.zeros((B, RWKV_HEADS, RWKV_HEAD, RWKV_HEAD), jnp.float32),
                               jnp.zeros((B, RWKV_COLS), xp.dtype), None)
        past = (gather_pages(cache_cmp_kv[l], page_table), gather_pages(cache_slc_kv[l], page_table),
                cache_win_kv[l], buf_pos)
        xs, st_s = trunk_layer(xs, pos_s, lp, state_rwkv[l], state_rwkv_shift[l], past)
        outs_p.append(st_p)
        outs_s.append(st_s)
    stack = lambda outs, i: jnp.stack([o[i] for o in outs])
    y_prompt = rms_norm(xp, g_final)
    y_sample = rms_norm(xs, g_final)
    return (y_prompt, y_sample,
            stack(outs_p, 0), stack(outs_p, 1), stack(outs_p, 2), stack(outs_p, 3), stack(outs_p, 4),
            stack(outs_s, 0), stack(outs_s, 1), stack(outs_s, 2), stack(outs_s, 3), stack(outs_s, 4))
```

```cpp
#include <hip/hip_runtime.h>
#include <hip/hip_cooperative_groups.h>
#include <cstdio>
#include <cstdint>
namespace cg = cooperative_groups;

#define LAS __attribute__((address_space(3)))
typedef unsigned short bf16_t;
typedef short bf16x8 __attribute__((ext_vector_type(8)));
typedef short bf16x4 __attribute__((ext_vector_type(4)));
typedef float f32x2 __attribute__((ext_vector_type(2)));
typedef float f32x4 __attribute__((ext_vector_type(4)));
typedef float f32x8 __attribute__((ext_vector_type(8)));
typedef float f32x16 __attribute__((ext_vector_type(16)));
typedef unsigned u32x2 __attribute__((ext_vector_type(2)));
typedef unsigned u32x4 __attribute__((ext_vector_type(4)));

constexpr int NTOK = 17408, NPT = 16384, TP = 4096;
constexpr int LDS_BYTES = 147456;
constexpr int NTHR = 512;

constexpr size_t O_YP = 0;
constexpr size_t O_YS = O_YP + 16777216;
constexpr size_t O_PCMP = O_YS + 1048576;
constexpr size_t O_PSLC = O_PCMP + 4194304;
constexpr size_t O_PWIN = O_PSLC + 4194304;
constexpr size_t O_PRWKV = O_PWIN + 524288;
constexpr size_t O_PSHIFT = O_PRWKV + 131072;
constexpr size_t O_SCMP = O_PSHIFT + 7296;
constexpr size_t O_SSLC = O_SCMP + 262144;
constexpr size_t O_SWIN = O_SSLC + 262144;
constexpr size_t O_SRWKV = O_SWIN + 16777216;
constexpr size_t O_SSHIFT = O_SRWKV + 4194304;

constexpr size_t AL(size_t x) { return (x + 255) & ~(size_t)255; }
constexpr size_t W_BT1 = 0;
constexpr size_t W_BTM = W_BT1 + AL(5376ull * 1024 * 2);
constexpr size_t W_BTO = W_BTM + AL(1024ull * 1024 * 2);
constexpr size_t W_BTGU = W_BTO + AL(1024ull * 1024 * 2);
constexpr size_t W_BTD = W_BTGU + AL(5632ull * 1024 * 2);
constexpr size_t W_BTC1 = W_BTD + AL(1024ull * 2816 * 2);
constexpr size_t W_BTC2 = W_BTC1 + AL(2ull * 256 * 1024 * 2);
constexpr size_t W_BIASC = W_BTC2 + AL(2ull * 64 * 128 * 2);
constexpr size_t W_BTDEC = W_BIASC + AL(2 * 256 * 4);
constexpr size_t W_BTAAA = W_BTDEC + AL(512 * 64 * 2);
constexpr size_t W_BTGATE = W_BTAAA + AL(512 * 64 * 2);
constexpr size_t W_ROPE = W_BTGATE + AL(512 * 160 * 2);
constexpr size_t W_H = W_ROPE + AL(4096 * 16 * 4);
constexpr size_t W_P = W_H + AL((size_t)NTOK * 1024 * 2);
constexpr size_t W_QC = W_P + AL((size_t)NTOK * 1824 * 2);
constexpr size_t W_QR = W_QC + AL((size_t)NTOK * 512 * 2);
constexpr size_t W_CPM = W_QR + AL((size_t)NTOK * 512 * 2);
constexpr size_t W_CSM = W_CPM + AL(2ull * 2048 * 1024 * 2);
constexpr size_t W_KS = W_CSM + AL(2ull * 32768 * 1024 * 2);
constexpr size_t W_VST = W_KS + AL(8ull * 4096 * 64 * 2);
constexpr size_t W_KW = W_VST + AL(8ull * 4096 * 64 * 2);
constexpr size_t W_VWT = W_KW + AL(8ull * 4096 * 64 * 2);
constexpr size_t W_KCP = W_VWT + AL(8ull * 4096 * 64 * 2);
constexpr size_t W_VCPT = W_KCP + AL(8ull * 256 * 64 * 2);
constexpr size_t W_KCS = W_VCPT + AL(8ull * 256 * 64 * 2);
constexpr size_t W_VCST = W_KCS + AL(256ull * 128 * 64 * 2);
constexpr size_t W_GATES = W_VCST + AL(256ull * 128 * 64 * 2);
constexpr size_t W_GN = W_GATES + AL((size_t)NTOK * 2048 * 2);
constexpr size_t W_R = W_GN + AL((size_t)NTOK * 24 * 4);
constexpr size_t RW_SZ = AL((size_t)NTOK * 512 * 4);
constexpr size_t W_DEC = W_R + RW_SZ;
constexpr size_t W_KH = W_DEC + RW_SZ;
constexpr size_t W_V = W_KH + RW_SZ;
constexpr size_t W_AV = W_V + RW_SZ;
constexpr size_t W_BV = W_AV + RW_SZ;
constexpr size_t W_G = W_BV + RW_SZ;
constexpr size_t W_YCAT = W_G + RW_SZ;
constexpr size_t W_MERGED = W_YCAT + AL((size_t)NTOK * 1024 * 2);
constexpr size_t W_X2 = W_MERGED + AL((size_t)NTOK * 1024 * 2);
constexpr size_t W_A2 = W_X2 + AL((size_t)NTOK * 1024 * 4);
constexpr size_t W_ACT = W_A2 + AL((size_t)NTOK * 1024 * 2);
constexpr size_t W_X3 = W_ACT + AL((size_t)NTOK * 2816 * 2);
constexpr size_t W_RS1 = W_X3 + AL((size_t)NTOK * 1024 * 4);
constexpr size_t W_RS2 = W_RS1 + AL((size_t)NTOK * 4);
constexpr size_t W_CTR = W_RS2 + AL((size_t)NTOK * 4);
constexpr size_t W_END = W_CTR + 256;

struct Params { const float* in[32]; float* out; unsigned char* ws; int ph_lo, ph_hi; };

typedef const __attribute__((address_space(4))) Params CParams;
__device__ __forceinline__ CParams& kparams() {
    CParams* kp = (CParams*)__builtin_amdgcn_kernarg_segment_ptr();
    asm volatile("" : "+s"(kp));
    return *kp;
}
__device__ __forceinline__ int opaque_tid() { int t = threadIdx.x; asm volatile("" : "+v"(t)); return t; }
__device__ __forceinline__ unsigned cvt_pk_bf16(float lo, float hi) { unsigned r; asm volatile("v_cvt_pk_bf16_f32 %0, %1, %2" : "=v"(r) : "v"(lo), "v"(hi)); return r; }
__device__ __forceinline__ float bf_lo(unsigned u) { return __uint_as_float(u << 16); }
__device__ __forceinline__ float bf_hi(unsigned u) { return __uint_as_float(u & 0xffff0000u); }
__device__ __forceinline__ float bf2f(bf16_t b) { return __uint_as_float(((unsigned)b) << 16); }
__device__ __forceinline__ bf16_t f2bf(float f) { return (bf16_t)(cvt_pk_bf16(f, 0.f) & 0xffffu); }
__device__ __forceinline__ u32x2 pack4(f32x4 v) { u32x2 r; r.x = cvt_pk_bf16(v[0], v[1]); r.y = cvt_pk_bf16(v[2], v[3]); return r; }
__device__ __forceinline__ bf16x8 pack8(float a0, float a1, float a2, float a3, float a4, float a5, float a6, float a7) {
    u32x4 r; r.x = cvt_pk_bf16(a0, a1); r.y = cvt_pk_bf16(a2, a3); r.z = cvt_pk_bf16(a4, a5); r.w = cvt_pk_bf16(a6, a7);
    return __builtin_bit_cast(bf16x8, r);
}
__device__ __forceinline__ f32x8 ld_bf8(const bf16_t* p) {
    const u32x4 v = *(const u32x4*)p; f32x8 o;
    o[0] = bf_lo(v.x); o[1] = bf_hi(v.x); o[2] = bf_lo(v.y); o[3] = bf_hi(v.y); o[4] = bf_lo(v.z); o[5] = bf_hi(v.z); o[6] = bf_lo(v.w); o[7] = bf_hi(v.w); return o;
}
__device__ __forceinline__ f32x4 ld_bf4(const bf16_t* p) {
    const u32x2 v = *(const u32x2*)p; f32x4 o; o[0] = bf_lo(v.x); o[1] = bf_hi(v.x); o[2] = bf_lo(v.y); o[3] = bf_hi(v.y); return o;
}
__device__ __forceinline__ float sigmoidf_(float x) { return 1.0f / (1.0f + __expf(-x)); }
__device__ __forceinline__ float dppf(float x, const int ctrl_sel) {
    const int xi = __float_as_int(x); int r;
    if (ctrl_sel == 0) r = __builtin_amdgcn_update_dpp(0, xi, 0xB1, 0xF, 0xF, false);
    else if (ctrl_sel == 1) r = __builtin_amdgcn_update_dpp(0, xi, 0x4E, 0xF, 0xF, false);
    else r = __builtin_amdgcn_update_dpp(0, xi, 0x141, 0xF, 0xF, false);
    return __int_as_float(r);
}
__device__ __forceinline__ float allreduce4(float x) { x += dppf(x, 0); x += dppf(x, 1); return x; }
__device__ __forceinline__ float allreduce8(float x) { x += dppf(x, 0); x += dppf(x, 1); x += dppf(x, 2); return x; }
__device__ __forceinline__ f32x4 mfma16(bf16x8 a, bf16x8 b, f32x4 c) { return __builtin_amdgcn_mfma_f32_16x16x32_bf16(a, b, c, 0, 0, 0); }
__device__ __forceinline__ f32x16 mfma32(bf16x8 a, bf16x8 b, f32x16 c) { return __builtin_amdgcn_mfma_f32_32x32x16_bf16(a, b, c, 0, 0, 0); }

namespace pg8 {
constexpr int BM = 256, BK = 64, HALF = 128, HTB = HALF * BK * 2, STAGE_BYTES = 8 * HTB, NXCD = 8, WGM = 8;
__host__ __device__ __forceinline__ int lds_byte(int r, int c) { const int st = (r >> 4) * 2 + (c >> 5), rr = r & 15, cc = c & 31, ob = rr * 64 + cc * 2; return st * 1024 + (ob ^ (((ob >> 9) & 1) << 5)); }
__host__ __device__ __forceinline__ void stage_rc(int b, int& R, int& C) { const int st = b / 1024, sb = b % 1024, swz = sb ^ (((sb >> 9) & 1) << 5); R = (st >> 1) * 16 + swz / 64; C = (st & 1) * 32 + (swz % 64) / 2; }
struct Unit { int pm, pn; };
struct Gemm { const bf16_t* A; const bf16_t* Bt; int M, N, K; };
struct StaticOrder {
    int nM, nN, nwg, G, c;
    __device__ void init(int M, int N, int G_, int c_) { nM = M / BM; nN = N / BM; nwg = nM * nN; G = G_; c = c_; }
    __device__ bool next(int i, Unit& u) const {
        const long L = (long)i * G + c; if (L >= nwg) return false;
        int wgid = (int)L; { const int q = nwg / NXCD, r = nwg % NXCD, xcd = wgid % NXCD, off = wgid / NXCD; wgid = (xcd < r ? xcd * (q + 1) : r * (q + 1) + (xcd - r) * q) + off; }
        const int nig = WGM * nN, gid = wgid / nig, fm = gid * WGM, gsz = (nM - fm) < WGM ? (nM - fm) : WGM;
        u.pm = fm + ((wgid % nig) % gsz); u.pn = (wgid % nig) / gsz; return true;
    }
};
struct OneUnit { Unit u; __device__ bool next(int i, Unit& o) const { if (i != 0) return false; o = u; return true; } };

template <class Epi, class Sched>
__device__ __forceinline__ void gemm_phase(LAS unsigned char* lds, const Gemm g, const Sched& S, const Epi& E) {
    const int tid = opaque_tid(), wid = __builtin_amdgcn_readfirstlane(tid >> 6), lane = tid & 63, wr = wid >> 2, wc = wid & 3, fr = lane & 15, fq = lane >> 4;
    const int K = g.K, nt = K / BK;
    unsigned voffA[2], voffB[2];
#pragma unroll
    for (int i = 0; i < 2; ++i) { int R, C; stage_rc(tid * 16 + i * 8192, R, C); voffA[i] = (unsigned)(R * K + C) * 2u; voffB[i] = voffA[i]; }
    const size_t kstep = (size_t)(BK * 2);
    const size_t hstep = (size_t)HALF * K * 2;
    const size_t tstep = 2 * hstep;
    const unsigned ldsw = (unsigned)wid * 1024u;
    const int aoff = lds_byte(wr * 64 + fr, fq * 8), boff = lds_byte(wc * 32 + fr, fq * 8);
#define PG8_SA(b, h) (((b) * 2 + (h)) * HTB)
#define PG8_SB(b, h) ((4 + (b) * 2 + (h)) * HTB)
#define PG8_STAGE(bufoff, gbase, voff) do { _Pragma("unroll") for (int _i = 0; _i < 2; ++_i) \
        __builtin_amdgcn_global_load_lds((const unsigned*)((const char*)(gbase) + (voff)[_i]), (LAS unsigned*)(lds + (bufoff) + ldsw + _i * 8192), 16, 0, 0); } while (0)
#define PG8_LDA(dst, b, h) do { _Pragma("unroll") for (int m = 0; m < 4; ++m) _Pragma("unroll") for (int k = 0; k < 2; ++k) dst[m][k] = *(const LAS bf16x8*)(lds + PG8_SA(b, h) + aoff + m * 2048 + k * 1024); } while (0)
#define PG8_LDB(dst, b, h) do { _Pragma("unroll") for (int n = 0; n < 2; ++n) _Pragma("unroll") for (int k = 0; k < 2; ++k) dst[n][k] = *(const LAS bf16x8*)(lds + PG8_SB(b, h) + boff + n * 2048 + k * 1024); } while (0)
#define PG8_MMA(ai, bj, At, Bt) do { __builtin_amdgcn_s_setprio(1); _Pragma("unroll") for (int m = 0; m < 4; ++m) _Pragma("unroll") for (int n = 0; n < 2; ++n) _Pragma("unroll") for (int k = 0; k < 2; ++k) \
        acc[ai][bj][m][n] = __builtin_amdgcn_mfma_f32_16x16x32_bf16(Bt[n][k], At[m][k], acc[ai][bj][m][n], 0, 0, 0); __builtin_amdgcn_s_setprio(0); } while (0)
#define PG8_WAIT_V(n) asm volatile("s_waitcnt vmcnt(" #n ")" ::: "memory")
#define PG8_WAIT_L(n) asm volatile("s_waitcnt lgkmcnt(" #n ")" ::: "memory")
#define PG8_BAR __builtin_amdgcn_s_barrier()
#define PG8_SCHED __builtin_amdgcn_sched_barrier(0)
    Unit cur, nxt; int ui = 0;
    if (!S.next(0, cur)) return;
    f32x4 acc[2][2][4][2];
#pragma unroll
    for (int a = 0; a < 2; ++a)
#pragma unroll
        for (int b = 0; b < 2; ++b)
#pragma unroll
            for (int m = 0; m < 4; ++m)
#pragma unroll
                for (int n = 0; n < 2; ++n) acc[a][b][m][n] = (f32x4){0.f, 0.f, 0.f, 0.f};
    bf16x8 At[4][2], B0[2][2], B1[2][2];
    const char* cA = (const char*)g.A + (size_t)cur.pm * tstep; const char* cB = (const char*)g.Bt + (size_t)cur.pn * tstep;
    PG8_STAGE(PG8_SB(0, 0), cB, voffB); PG8_STAGE(PG8_SA(0, 0), cA, voffA); PG8_STAGE(PG8_SB(0, 1), cB + hstep, voffB); PG8_STAGE(PG8_SA(0, 1), cA + hstep, voffA);
    if (wr == 1) PG8_BAR;
    PG8_WAIT_V(4); PG8_BAR;
    PG8_STAGE(PG8_SB(1, 0), cB + kstep, voffB); PG8_STAGE(PG8_SA(1, 0), cA + kstep, voffA); PG8_STAGE(PG8_SB(1, 1), cB + hstep + kstep, voffB);
    PG8_WAIT_V(6); PG8_BAR;
    for (;;) {
        const bool has_next = S.next(ui + 1, nxt);
        const char* nA = has_next ? (const char*)g.A + (size_t)nxt.pm * tstep : cA; const char* nB = has_next ? (const char*)g.Bt + (size_t)nxt.pn * tstep : cB;
        for (int t = 0; t < nt; t += 2) {
            const bool last = (t == nt - 2);
            const char* a1 = cA + (size_t)(t + 1) * kstep;
            const char* a2 = last ? nA : cA + (size_t)(t + 2) * kstep; const char* b2 = last ? nB : cB + (size_t)(t + 2) * kstep;
            const char* a3 = a2 + kstep; const char* b3 = b2 + kstep;
            if constexpr (Epi::HAS_MID) { if (t == Epi::MID_T) E.mid(acc, cur, wr, wc, fr, fq); }
            PG8_LDB(B0, 0, 0); PG8_SCHED; PG8_LDA(At, 0, 0); PG8_STAGE(PG8_SA(1, 1), a1 + hstep, voffA);
            PG8_WAIT_L(8); PG8_BAR; PG8_WAIT_L(0); PG8_MMA(0, 0, At, B0); PG8_BAR; PG8_SCHED;
            PG8_LDB(B1, 0, 1); PG8_STAGE(PG8_SB(0, 0), b2, voffB);
            PG8_BAR; PG8_WAIT_L(0); PG8_MMA(0, 1, At, B1); PG8_BAR;
            PG8_LDA(At, 0, 1); PG8_STAGE(PG8_SA(0, 0), a2, voffA);
            PG8_BAR; PG8_WAIT_L(0); PG8_MMA(1, 0, At, B0); PG8_BAR; PG8_SCHED;
            PG8_STAGE(PG8_SB(0, 1), b2 + hstep, voffB);
            PG8_WAIT_V(6); PG8_BAR; PG8_MMA(1, 1, At, B1); PG8_BAR;
            PG8_LDB(B0, 1, 0); PG8_SCHED; PG8_LDA(At, 1, 0); PG8_STAGE(PG8_SA(0, 1), a2 + hstep, voffA);
            PG8_WAIT_L(8); PG8_BAR; PG8_WAIT_L(0); PG8_MMA(0, 0, At, B0); PG8_BAR; PG8_SCHED;
            PG8_LDB(B1, 1, 1); PG8_STAGE(PG8_SB(1, 0), b3, voffB);
            PG8_BAR; PG8_WAIT_L(0); PG8_MMA(0, 1, At, B1); PG8_BAR;
            PG8_LDA(At, 1, 1); PG8_STAGE(PG8_SA(1, 0), a3, voffA);
            PG8_BAR; PG8_WAIT_L(0); PG8_MMA(1, 0, At, B0); PG8_BAR; PG8_SCHED;
            PG8_STAGE(PG8_SB(1, 1), b3 + hstep, voffB);
            PG8_WAIT_V(6); PG8_BAR; PG8_MMA(1, 1, At, B1); PG8_BAR;
        }
        if constexpr (!Epi::AFTER_DRAIN) { E(acc, cur, wr, wc, fr, fq); }
        if (!has_next) break;
#pragma unroll
        for (int a = 0; a < 2; ++a)
#pragma unroll
            for (int b = 0; b < 2; ++b)
#pragma unroll
                for (int m = 0; m < 4; ++m)
#pragma unroll
                    for (int n = 0; n < 2; ++n) acc[a][b][m][n] = (f32x4){0.f, 0.f, 0.f, 0.f};
        cur = nxt; cA = nA; cB = nB; ++ui;
    }
    PG8_WAIT_V(0);
    if (wr == 0) PG8_BAR;
    PG8_BAR;
    if constexpr (Epi::AFTER_DRAIN) { E.fused(acc, cur, wr, wc, fr, fq, lds, wid, lane); }
#undef PG8_SA
#undef PG8_SB
#undef PG8_STAGE
#undef PG8_LDA
#undef PG8_LDB
#undef PG8_MMA
#undef PG8_WAIT_V
#undef PG8_WAIT_L
#undef PG8_BAR
#undef PG8_SCHED
}
}
using pg8::Unit;

struct Tok { int is_p, b, t, pos; };
__device__ __forceinline__ Tok tok_of(int m) { Tok k; if (m < NPT) { k.is_p = 1; k.b = m >> 12; k.t = m & 4095; k.pos = k.t; } else { const int s = m - NPT; k.is_p = 0; k.b = s >> 3; k.t = s & 7; k.pos = 2048 + k.t; } return k; }

template <class RM, class CM>
__device__ __forceinline__ void convT(bf16_t* dst, int ldd, int koff, int K, int nN, const float* src, int srcN, RM rowmap, CM colmap, size_t gtid, size_t gsz) {
    const size_t total = (size_t)nN * (K / 8);
    for (size_t i = gtid; i < total; i += gsz) {
        const int n = (int)(i % nN), kg = (int)(i / nN); const int c = colmap(n);
        float v[8];
#pragma unroll
        for (int j = 0; j < 8; ++j) v[j] = (c >= 0) ? src[(size_t)(kg * 8 + j) * srcN + c] : 0.f;
        u32x4 w; w.x = cvt_pk_bf16(v[0], v[1]); w.y = cvt_pk_bf16(v[2], v[3]); w.z = cvt_pk_bf16(v[4], v[5]); w.w = cvt_pk_bf16(v[6], v[7]);
        *(u32x4*)(dst + (size_t)rowmap(n) * ldd + koff + kg * 8) = w;
    }
}

__device__ __forceinline__ void phase0(int bid, int nb) {
    CParams& p = kparams();
    const int tid = threadIdx.x, lane = tid & 63;
    const size_t gtid = (size_t)bid * NTHR + tid, gsz = (size_t)nb * NTHR;
    unsigned char* ws = p.ws;
    auto idm = [](int n) { return n; };
    convT((bf16_t*)(ws + W_BT1), 1024, 0, 1024, 5376, p.in[9], 5176, idm,
          [](int n) { return n < 1824 ? n : (n < 1848 ? 3104 + (n - 1824) : (n < 2048 ? -1 : (n < 3328 ? 1824 + (n - 2048) : 3128 + (n - 3328)))); }, gtid, gsz);
    convT((bf16_t*)(ws + W_BTM), 1024, 0, 512, 1024, p.in[24], 1024, idm, idm, gtid, gsz);
    convT((bf16_t*)(ws + W_BTM), 1024, 512, 512, 1024, p.in[25], 1024, idm, idm, gtid, gsz);
    convT((bf16_t*)(ws + W_BTO), 1024, 0, 1024, 1024, p.in[26], 1024, idm, idm, gtid, gsz);
    convT((bf16_t*)(ws + W_BTGU), 1024, 0, 1024, 2816, p.in[28], 2816, [](int n) { return 256 * (n >> 7) + (n & 127); }, idm, gtid, gsz);
    convT((bf16_t*)(ws + W_BTGU), 1024, 0, 1024, 2816, p.in[29], 2816, [](int n) { return 256 * (n >> 7) + 128 + (n & 127); }, idm, gtid, gsz);
    convT((bf16_t*)(ws + W_BTD), 2816, 0, 2816, 1024, p.in[30], 1024, idm, idm, gtid, gsz);
    for (int c = 0; c < 2; ++c)
        for (int hf = 0; hf < 2; ++hf)
            convT((bf16_t*)(ws + W_BTC1) + (size_t)(c * 256 + hf * 128) * 1024, 1024, 0, 1024, 128, p.in[22] + (size_t)(c * 2048 + hf * 1024) * 128, 128, idm, idm, gtid, gsz);
    for (int c = 0; c < 2; ++c) convT((bf16_t*)(ws + W_BTC2) + (size_t)c * 64 * 128, 128, 0, 128, 64, p.in[23] + (size_t)c * 128 * 64, 64, idm, idm, gtid, gsz);
    convT((bf16_t*)(ws + W_BTDEC), 64, 0, 64, 512, p.in[12], 512, idm, idm, gtid, gsz);
    convT((bf16_t*)(ws + W_BTAAA), 64, 0, 64, 512, p.in[14], 512, idm, idm, gtid, gsz);
    convT((bf16_t*)(ws + W_BTGATE), 160, 0, 160, 512, p.in[15], 512, idm, idm, gtid, gsz);
    for (size_t i = gtid; i < 4096 * 8; i += gsz) {
        const int pos = (int)(i >> 3), k = (int)(i & 7);
        const float inv = powf(500000.0f, -(float)k / 8.0f); const float ang = (float)pos * inv;
        float s, c; sincosf(ang, &s, &c);
        float* r = (float*)(ws + W_ROPE); r[i * 2] = c; r[i * 2 + 1] = s;
    }
    for (size_t i = gtid; i < (size_t)NTOK; i += gsz) { ((float*)(ws + W_RS1))[i] = 0.f; ((float*)(ws + W_RS2))[i] = 0.f; }
    if (gtid < 64) ((unsigned*)(ws + W_CTR))[gtid] = 0u;
    {
        const int gw = (int)(gtid >> 6), nw = (int)(gsz >> 6);
        for (int o = gw; o < 512; o += nw) {
            const int c = o >> 8, n = o & 255, hf = n >> 7, hh = n & 127;
            const float* pe = p.in[21] + (size_t)(c * 32 + hf * 16) * 64; const float* w1 = p.in[22] + (size_t)(c * 2048 + hf * 1024) * 128 + hh;
            float s = 0.f;
            for (int k = lane; k < 1024; k += 64) s += pe[k] * w1[(size_t)k * 128];
#pragma unroll
            for (int o2 = 32; o2 > 0; o2 >>= 1) s += __shfl_xor(s, o2);
            if (lane == 0) ((float*)(ws + W_BIASC))[o] = s;
        }
    }
    {
        const int gw = (int)(gtid >> 6), nw = (int)(gsz >> 6);
        const float* gm = p.in[8];
        for (int m = gw; m < NTOK; m += nw) {
            const float* x = (m < NPT) ? p.in[0] + (size_t)m * 1024 : p.in[1] + (size_t)(m - NPT) * 1024;
            f32x4 v[4]; float ss = 0.f;
#pragma unroll
            for (int j = 0; j < 4; ++j) { v[j] = *(const f32x4*)(x + j * 256 + lane * 4); ss += v[j][0] * v[j][0] + v[j][1] * v[j][1] + v[j][2] * v[j][2] + v[j][3] * v[j][3]; }
#pragma unroll
            for (int o2 = 32; o2 > 0; o2 >>= 1) ss += __shfl_xor(ss, o2);
            const float rs = rsqrtf(ss * (1.0f / 1024.0f) + 1e-6f);
            bf16_t* h = (bf16_t*)(ws + W_H) + (size_t)m * 1024;
#pragma unroll
            for (int j = 0; j < 4; ++j) { const f32x4 g = *(const f32x4*)(gm + j * 256 + lane * 4); *(u32x2*)(h + j * 256 + lane * 4) = pack4(v[j] * rs * g); }
        }
    }
    {
        const int* pt = (const int*)p.in[7]; const float* cc = p.in[2]; bf16_t* csm = (bf16_t*)(ws + W_CSM);
        const size_t total = 128ull * 2048 * 32;
        for (size_t i = gtid; i < total; i += gsz) {
            const int d8 = (int)(i & 7), g = (int)((i >> 3) & 1), c = (int)((i >> 4) & 1); const int rowi = (int)((i >> 5) & 2047), seq = (int)(i >> 16);
            const int page = pt[seq * 16 + (rowi >> 7)];
            const float* src = cc + ((size_t)page * 128 + (rowi & 127)) * 256 + c * 128 + g * 64 + d8 * 8;
            const f32x4 a = *(const f32x4*)src, b = *(const f32x4*)(src + 4);
            const int n = rowi >> 4, l = rowi & 15;
            u32x4 w; w.x = cvt_pk_bf16(a[0], a[1]); w.y = cvt_pk_bf16(a[2], a[3]); w.z = cvt_pk_bf16(b[0], b[1]); w.w = cvt_pk_bf16(b[2], b[3]);
            *(u32x4*)(csm + ((size_t)c * 32768 + (size_t)(seq * 2 + g) * 128 + n) * 1024 + l * 64 + d8 * 8) = w;
        }
    }
    {
        const f32x4* src = (const f32x4*)p.in[4]; f32x4* dst = (f32x4*)(p.out + O_SWIN);
        const size_t total = 128ull * 504 * 64;
        for (size_t i = gtid; i < total; i += gsz) { const size_t b = i / (504 * 64), r = i % (504 * 64); dst[b * 512 * 64 + r] = src[b * 512 * 64 + 8 * 64 + r]; }
    }
}

__device__ __forceinline__ f32x4 rope4(f32x4 v, int fq, int pos, const float* rope) {
    f32x4 o;
#pragma unroll
    for (int j = 0; j < 4; ++j) {
        const float other = __shfl_xor(v[j], 32); const int i = 4 * (fq & 1) + j; const f32x2 cs = *(const f32x2*)(rope + pos * 16 + i * 2);
        o[j] = (fq < 2) ? v[j] * cs.x - other * cs.y : v[j] * cs.x + other * cs.y;
    }
    return o;
}

struct EpiG1 {
    static constexpr bool AFTER_DRAIN = false, HAS_MID = false; static constexpr int MID_T = 0;
    float* out; unsigned char* ws;
    __device__ __forceinline__ void mid(f32x4 (&)[2][2][4][2], const Unit&, int, int, int, int) const {}
    __device__ __forceinline__ void operator()(const f32x4 (&acc)[2][2][4][2], const Unit& u, int wr, int wc, int fr, int fq) const {
        const int pn = u.pn; const float* rope = (const float*)(ws + W_ROPE);
#pragma unroll
        for (int ai = 0; ai < 2; ++ai)
#pragma unroll
            for (int m = 0; m < 4; ++m) {
                const int row = u.pm * 256 + ai * 128 + wr * 64 + m * 16 + fr; const Tok tk = tok_of(row);
#pragma unroll
                for (int bj = 0; bj < 2; ++bj)
#pragma unroll
                    for (int n = 0; n < 2; ++n) {
                        const int cl = bj * 128 + wc * 32 + n * 16 + fq * 4; f32x4 v = acc[ai][bj][m][n];
                        if (pn < 8) {
                            const int c = pn * 256 + cl;
                            if (c < 1824) {
                                *(u32x2*)((bf16_t*)(ws + W_P) + (size_t)row * 1824 + c) = pack4(v);
                                if (tk.is_p) { if (tk.t == 4095) *(f32x4*)(out + O_PSHIFT + (size_t)tk.b * 1824 + c) = v; }
                                else { if (tk.t == 7) *(f32x4*)(out + O_SSHIFT + (size_t)tk.b * 1824 + c) = v; }
                            } else if (c < 1848) {
                                f32x4 s; s[0] = sigmoidf_(v[0]); s[1] = sigmoidf_(v[1]); s[2] = sigmoidf_(v[2]); s[3] = sigmoidf_(v[3]);
                                *(f32x4*)((float*)(ws + W_GN) + (size_t)row * 24 + (c - 1824)) = s;
                            }
                        } else if (pn < 10) {
                            const int c = (pn - 8) * 256 + cl; v = v * 0.125f;
                            *(u32x2*)((bf16_t*)(ws + W_QC) + (size_t)row * 512 + c) = pack4(v);
                            if ((wc & 1) == 0 && n == 0) v = rope4(v, fq, tk.pos, rope);
                            *(u32x2*)((bf16_t*)(ws + W_QR) + (size_t)row * 512 + c) = pack4(v);
                        } else if (pn < 13) {
                            const int g = wc >> 1, d = (wc & 1) * 32 + n * 16 + fq * 4;
                            if (pn > 10 && bj == 0 && (wc & 1) == 0 && n == 0) v = rope4(v, fq, tk.pos, rope);
                            if (pn == 10) {
                                *(f32x4*)(out + (tk.is_p ? O_PCMP + (size_t)row * 256 : O_SCMP + (size_t)(row - NPT) * 256) + cl) = v;
                                if (tk.is_p) *(u32x2*)((bf16_t*)(ws + W_CPM) + (size_t)bj * 2048 * 1024 + (size_t)((tk.b * 2 + g) * 256 + (tk.t >> 4)) * 1024 + (tk.t & 15) * 64 + d) = pack4(v);
                            } else {
                                if (pn == 11) *(f32x4*)(out + (tk.is_p ? O_PSLC + (size_t)row * 256 : O_SSLC + (size_t)(row - NPT) * 256) + cl) = v;
                                else {
                                    if (tk.is_p) { if (tk.t >= 3584) *(f32x4*)(out + O_PWIN + ((size_t)tk.b * 512 + (tk.t - 3584)) * 256 + cl) = v; }
                                    else *(f32x4*)(out + O_SWIN + ((size_t)tk.b * 512 + 504 + tk.t) * 256 + cl) = v;
                                }
                                if (tk.is_p) {
                                    if (bj == 0) *(u32x2*)((bf16_t*)(ws + (pn == 11 ? W_KS : W_KW)) + ((size_t)(tk.b * 2 + g) * 4096 + tk.t) * 64 + d) = pack4(v);
                                    else { bf16_t* vt = (bf16_t*)(ws + (pn == 11 ? W_VST : W_VWT)) + ((size_t)(tk.b * 2 + g) * 64 + d) * 4096 + tk.t;
#pragma unroll
                                        for (int j = 0; j < 4; ++j) vt[(size_t)j * 4096] = f2bf(v[j]); }
                                }
                            }
                        } else {
                            f32x4 s; s[0] = sigmoidf_(v[0]); s[1] = sigmoidf_(v[1]); s[2] = sigmoidf_(v[2]); s[3] = sigmoidf_(v[3]);
                            *(u32x2*)((bf16_t*)(ws + W_GATES) + (size_t)row * 2048 + (pn - 13) * 256 + cl) = pack4(s);
                        }
                    }
            }
    }
};

struct EpiCmp {
    static constexpr bool AFTER_DRAIN = true, HAS_MID = false; static constexpr int MID_T = 0;
    unsigned char* ws; int gs  ; int per_c  ; bf16_t* KC; bf16_t* VCT;
    __device__ __forceinline__ void mid(f32x4 (&)[2][2][4][2], const Unit&, int, int, int, int) const {}
    __device__ __forceinline__ void operator()(const f32x4 (&)[2][2][4][2], const Unit&, int, int, int, int) const {}
    __device__ __forceinline__ void fused(f32x4 (&acc)[2][2][4][2], const Unit& u, int wr, int wc, int fr, int fq, LAS unsigned char* lds, int wid, int lane) const {
        const int c = u.pn, pmr = u.pm - c * per_c;
        LAS float* HS = (LAS float*)lds;
        LAS bf16_t* HB = (LAS bf16_t*)lds;
        const float* bias = (const float*)(ws + W_BIASC) + c * 256;
#pragma unroll
        for (int ai = 0; ai < 2; ++ai)
#pragma unroll
            for (int m = 0; m < 4; ++m) { const int rl = ai * 128 + wr * 64 + m * 16 + fr;
#pragma unroll
                for (int n = 0; n < 2; ++n) *(LAS f32x4*)(HS + rl * 132 + wc * 32 + n * 16 + fq * 4) = acc[ai][1][m][n]; }
        __syncthreads();
#pragma unroll
        for (int ai = 0; ai < 2; ++ai)
#pragma unroll
            for (int m = 0; m < 4; ++m) { const int rl = ai * 128 + wr * 64 + m * 16 + fr; const bool ok = (rl % gs) < gs - 1;
#pragma unroll
                for (int n = 0; n < 2; ++n) { const int h = wc * 32 + n * 16 + fq * 4;
                    f32x4 r = (f32x4){0.f, 0.f, 0.f, 0.f};
                    if (ok) { const f32x4 hs = *(const LAS f32x4*)(HS + (rl + 1) * 132 + h); const f32x4 b0 = *(const f32x4*)(bias + h), b1 = *(const f32x4*)(bias + 128 + h);
                        const f32x4 x = acc[ai][0][m][n] + hs + b0 + b1;
#pragma unroll
                        for (int j = 0; j < 4; ++j) r[j] = x[j] * sigmoidf_(x[j]); }
                    acc[ai][0][m][n] = r; } }
        __syncthreads();
#pragma unroll
        for (int ai = 0; ai < 2; ++ai)
#pragma unroll
            for (int m = 0; m < 4; ++m) { const int rl = ai * 128 + wr * 64 + m * 16 + fr;
#pragma unroll
                for (int n = 0; n < 2; ++n) *(LAS u32x2*)(HB + rl * 136 + wc * 32 + n * 16 + fq * 4) = pack4(acc[ai][0][m][n]); }
        __syncthreads();
        const bf16_t* w2 = (const bf16_t*)(ws + W_BTC2) + (size_t)c * 64 * 128;
#pragma unroll
        for (int rt = 0; rt < 2; ++rt) {
            bf16x8 hfr[4];
#pragma unroll
            for (int ks = 0; ks < 4; ++ks) hfr[ks] = *(const LAS bf16x8*)(HB + (wid * 32 + rt * 16 + fr) * 136 + ks * 32 + fq * 8);
#pragma unroll
            for (int ct = 0; ct < 4; ++ct) {
                f32x4 d = (f32x4){0.f, 0.f, 0.f, 0.f};
#pragma unroll
                for (int ks = 0; ks < 4; ++ks) { const bf16x8 wf = *(const bf16x8*)(w2 + (size_t)(ct * 16 + fr) * 128 + ks * 32 + fq * 8);
                    d = (c == 0) ? mfma16(wf, hfr[ks], d) : mfma16(hfr[ks], wf, d); }
                if (c == 0) {
                    const size_t Rg = (size_t)pmr * 256 + wid * 32 + rt * 16 + fr;
                    *(u32x2*)(KC + Rg * 64 + ct * 16 + fq * 4) = pack4(d);
                } else {
                    const size_t Rg = (size_t)pmr * 256 + wid * 32 + rt * 16 + fq * 4; const size_t pair = Rg / gs, nn = Rg % gs;
                    *(u32x2*)(VCT + (pair * 64 + ct * 16 + fr) * gs + nn) = pack4(d);
                }
            }
        }
        __syncthreads();
    }
};

__device__ __forceinline__ void phase1(LAS unsigned char* lds, int bid, int nb) {
    CParams& p = kparams();
    {
        pg8::Gemm g{(const bf16_t*)(p.ws + W_CSM), (const bf16_t*)(p.ws + W_BTC1), 65536, 512, 1024};
        EpiCmp E{p.ws, 128, 128, (bf16_t*)(p.ws + W_KCS), (bf16_t*)(p.ws + W_VCST)};
        for (int uidx = bid; uidx < 256; uidx += nb) { pg8::OneUnit S{{uidx, uidx >> 7}}; pg8::gemm_phase(lds, g, S, E); }
    }
    {
        pg8::Gemm g{(const bf16_t*)(p.ws + W_H), (const bf16_t*)(p.ws + W_BT1), NTOK, 5376, 1024};
        pg8::StaticOrder S; S.init(NTOK, 5376, nb, bid);
        EpiG1 E{p.out, p.ws};
        pg8::gemm_phase(lds, g, S, E);
    }
}

__device__ __forceinline__ f32x8 prep_xs8(const bf16_t* prow, const bf16_t* pprev, const float* shift0, const float* mu, int c0) {
    const f32x8 pc = ld_bf8(prow + c0); f32x8 pp;
    if (pprev) pp = ld_bf8(pprev + c0);
    else if (shift0) { const f32x4 a = *(const f32x4*)(shift0 + c0), b = *(const f32x4*)(shift0 + c0 + 4); pp = (f32x8){a[0], a[1], a[2], a[3], b[0], b[1], b[2], b[3]}; }
    else pp = (f32x8){0.f, 0.f, 0.f, 0.f, 0.f, 0.f, 0.f, 0.f};
    const f32x4 m0 = *(const f32x4*)(mu + c0), m1 = *(const f32x4*)(mu + c0 + 4);
    const f32x8 m = (f32x8){m0[0], m0[1], m0[2], m0[3], m1[0], m1[1], m1[2], m1[3]};
    return pc + (pp - pc) * m;
}
__device__ __forceinline__ f32x4 prep_xs4(const bf16_t* prow, const bf16_t* pprev, const float* shift0, const float* mu, int c0) {
    const f32x4 pc = ld_bf4(prow + c0); f32x4 pp;
    if (pprev) pp = ld_bf4(pprev + c0);
    else if (shift0) pp = *(const f32x4*)(shift0 + c0);
    else pp = (f32x4){0.f, 0.f, 0.f, 0.f};
    const f32x4 m = *(const f32x4*)(mu + c0);
    return pc + (pp - pc) * m;
}

__device__ __forceinline__ void prep_group(CParams& p, int grp, int lane) {
    unsigned char* ws = p.ws;
    const int fr = lane & 15, fq = lane >> 4;
    const int m = grp * 16 + fr; const Tok tk = tok_of(m);
    const bf16_t* prow = (const bf16_t*)(ws + W_P) + (size_t)m * 1824;
    const bf16_t* pprev = (tk.t > 0) ? prow - 1824 : nullptr;
    const float* shift0 = (!tk.is_p && tk.t == 0) ? p.in[6] + (size_t)tk.b * 1824 : nullptr;
    const float* mu = p.in[10];
    bf16x8 Adec[2], Aaaa[2], Agate[5];
#pragma unroll
    for (int ks = 0; ks < 2; ++ks) {
        const f32x8 x = prep_xs8(prow, pprev, shift0, mu, 512 + ks * 32 + fq * 8);
        Adec[ks] = pack8(tanhf(x[0]), tanhf(x[1]), tanhf(x[2]), tanhf(x[3]), tanhf(x[4]), tanhf(x[5]), tanhf(x[6]), tanhf(x[7]));
        const f32x8 y = prep_xs8(prow, pprev, shift0, mu, 1600 + ks * 32 + fq * 8);
        Aaaa[ks] = pack8(y[0], y[1], y[2], y[3], y[4], y[5], y[6], y[7]);
    }
#pragma unroll
    for (int ks = 0; ks < 5; ++ks) {
        const f32x8 x = prep_xs8(prow, pprev, shift0, mu, 1664 + ks * 32 + fq * 8);
        Agate[ks] = pack8(sigmoidf_(x[0]), sigmoidf_(x[1]), sigmoidf_(x[2]), sigmoidf_(x[3]), sigmoidf_(x[4]), sigmoidf_(x[5]), sigmoidf_(x[6]), sigmoidf_(x[7]));
    }
    const bf16_t* Wd = (const bf16_t*)(ws + W_BTDEC); const bf16_t* Wa = (const bf16_t*)(ws + W_BTAAA); const bf16_t* Wg = (const bf16_t*)(ws + W_BTGATE);
    float* oR = (float*)(ws + W_R) + (size_t)m * 512; float* oDEC = (float*)(ws + W_DEC) + (size_t)m * 512; float* oKH = (float*)(ws + W_KH) + (size_t)m * 512;
    float* oV = (float*)(ws + W_V) + (size_t)m * 512; float* oAV = (float*)(ws + W_AV) + (size_t)m * 512; float* oBV = (float*)(ws + W_BV) + (size_t)m * 512; float* oG = (float*)(ws + W_G) + (size_t)m * 512;
    for (int h = 0; h < 8; ++h) {
        f32x4 kk[4], kx[4], aa[4]; float ss = 0.f;
#pragma unroll
        for (int nt = 0; nt < 4; ++nt) {
            const int n0 = h * 64 + nt * 16; const int nc = n0 + 4 * fq;
            f32x4 aw = (f32x4){0.f, 0.f, 0.f, 0.f}, a_a = aw, ag = aw;
#pragma unroll
            for (int ks = 0; ks < 2; ++ks) {
                aw = mfma16(*(const bf16x8*)(Wd + (size_t)(n0 + fr) * 64 + ks * 32 + fq * 8), Adec[ks], aw);
                a_a = mfma16(*(const bf16x8*)(Wa + (size_t)(n0 + fr) * 64 + ks * 32 + fq * 8), Aaaa[ks], a_a);
            }
#pragma unroll
            for (int ks = 0; ks < 5; ++ks) ag = mfma16(*(const bf16x8*)(Wg + (size_t)(n0 + fr) * 160 + ks * 32 + fq * 8), Agate[ks], ag);
            const f32x4 xr = prep_xs4(prow, pprev, shift0, mu, nc), xk = prep_xs4(prow, pprev, shift0, mu, 576 + nc), xv = prep_xs4(prow, pprev, shift0, mu, 1088 + nc);
            const f32x4 w0 = *(const f32x4*)(p.in[11] + nc), a0 = *(const f32x4*)(p.in[13] + nc), k_k = *(const f32x4*)(p.in[16] + nc);
            f32x4 dec, av;
#pragma unroll
            for (int j = 0; j < 4; ++j) {
                const float z = -(w0[j] + aw[j]);
                const float sp = fmaxf(z, 0.f) + log1pf(__expf(-fabsf(z)));
                const float w = -sp - 0.5f;
                dec[j] = __expf(-__expf(w));
                av[j] = sigmoidf_(a0[j] + a_a[j]);
            }
            const f32x4 kr = xk * k_k; ss += kr[0] * kr[0] + kr[1] * kr[1] + kr[2] * kr[2] + kr[3] * kr[3];
            kk[nt] = kr; kx[nt] = xk; aa[nt] = av;
            *(f32x4*)(oR + nc) = xr; *(f32x4*)(oDEC + nc) = dec; *(f32x4*)(oV + nc) = xv; *(f32x4*)(oG + nc) = ag;
        }
        ss += __shfl_xor(ss, 16); ss += __shfl_xor(ss, 32);
        const float inv = rsqrtf(fmaxf(ss, 1e-24f));
#pragma unroll
        for (int nt = 0; nt < 4; ++nt) {
            const int nc = h * 64 + nt * 16 + 4 * fq;
            const f32x4 k_a = *(const f32x4*)(p.in[17] + nc);
            const f32x4 kkn = kk[nt] * inv;
            *(f32x4*)(oKH + nc) = kx[nt] * (1.0f + (aa[nt] - 1.0f) * k_a);
            *(f32x4*)(oAV + nc) = -kkn;
            *(f32x4*)(oBV + nc) = kkn * aa[nt];
        }
    }
}

__device__ __forceinline__ void phase2(LAS unsigned char* lds, int bid, int nb) {
    CParams& p = kparams();
    {
        pg8::Gemm g{(const bf16_t*)(p.ws + W_CPM), (const bf16_t*)(p.ws + W_BTC1), 4096, 512, 1024};
        EpiCmp E{p.ws, 256, 8, (bf16_t*)(p.ws + W_KCP), (bf16_t*)(p.ws + W_VCPT)};
        for (int uidx = bid; uidx < 16; uidx += nb) { pg8::OneUnit S{{uidx, uidx >> 3}}; pg8::gemm_phase(lds, g, S, E); }
    }
    const int wv = threadIdx.x >> 6, lane = threadIdx.x & 63;
    const int nwaves = nb * 8;
    for (int grp = ((nb - 1 - bid) * 8 + wv); grp < NTOK / 16; grp += nwaves) prep_group(p, grp, lane);
}

__device__ __forceinline__ void scan_unit(CParams& p, LAS unsigned char* lds, int unit) {
    unsigned char* ws = p.ws;
    const int tid = opaque_tid(), i = tid >> 3, q = tid & 7;
    int T, m0, h; const float* S0 = nullptr; float* Sout;
    if (unit < 32) { const int b = unit >> 3; h = unit & 7; T = 4096; m0 = b * 4096; Sout = p.out + O_PRWKV + (size_t)unit * 4096; }
    else { const int su = unit - 32; const int seq = su >> 3; h = su & 7; T = 8; m0 = NPT + seq * 8; S0 = p.in[5] + (size_t)su * 4096; Sout = p.out + O_SRWKV + (size_t)su * 4096; }
    LAS float* buf = (LAS float*)lds; LAS float* Yb = buf + 2 * 6 * 16 * 64;
    float S[8];
    if (S0) { const f32x4 a = *(const f32x4*)(S0 + i * 64 + q * 8), b = *(const f32x4*)(S0 + i * 64 + q * 8 + 4); S[0] = a[0]; S[1] = a[1]; S[2] = a[2]; S[3] = a[3]; S[4] = b[0]; S[5] = b[1]; S[6] = b[2]; S[7] = b[3]; }
    else {
#pragma unroll
        for (int j = 0; j < 8; ++j) S[j] = 0.f; }
    const int nch = (T + 15) >> 4;
    f32x4 stg[3];
    auto gload = [&](int c) {
#pragma unroll
        for (int k = 0; k < 3; ++k) { const int idx = tid + 512 * k; const int ar = idx >> 8, st = (idx >> 4) & 15, f4 = idx & 15; const int t = c * 16 + st;
            stg[k] = (t < T) ? *(const f32x4*)((const float*)(ws + W_R + (size_t)ar * RW_SZ) + (size_t)(m0 + t) * 512 + h * 64 + f4 * 4) : (f32x4){0.f, 0.f, 0.f, 0.f}; }
    };
    auto lstore = [&](int bi) {
#pragma unroll
        for (int k = 0; k < 3; ++k) { const int idx = tid + 512 * k; const int ar = idx >> 8, st = (idx >> 4) & 15, f4 = idx & 15;
            *(LAS f32x4*)(buf + ((bi * 6 + ar) * 16 + st) * 64 + f4 * 4) = stg[k]; }
    };
    __syncthreads();
    gload(0); lstore(0);
    __syncthreads();
    const float* rk = p.in[18] + h * 64; const float* lnw = p.in[19] + h * 64; const float* lnb = p.in[20] + h * 64;
    for (int c = 0; c < nch; ++c) {
        const int bi = c & 1; const int ns = (T - c * 16) < 16 ? (T - c * 16) : 16;
        if (c + 1 < nch) gload(c + 1);
        LAS const float* bb = buf + bi * 6 * 16 * 64;
        for (int s = 0; s < ns; ++s) {
            const f32x4 r0 = *(LAS const f32x4*)(bb + (0 * 16 + s) * 64 + q * 8), r1 = *(LAS const f32x4*)(bb + (0 * 16 + s) * 64 + q * 8 + 4);
            const f32x4 d0 = *(LAS const f32x4*)(bb + (1 * 16 + s) * 64 + q * 8), d1 = *(LAS const f32x4*)(bb + (1 * 16 + s) * 64 + q * 8 + 4);
            const f32x4 k0 = *(LAS const f32x4*)(bb + (2 * 16 + s) * 64 + q * 8), k1 = *(LAS const f32x4*)(bb + (2 * 16 + s) * 64 + q * 8 + 4);
            const float vi = bb[(3 * 16 + s) * 64 + i];
            const f32x4 a0 = *(LAS const f32x4*)(bb + (4 * 16 + s) * 64 + q * 8), a1 = *(LAS const f32x4*)(bb + (4 * 16 + s) * 64 + q * 8 + 4);
            const f32x4 b0 = *(LAS const f32x4*)(bb + (5 * 16 + s) * 64 + q * 8), b1 = *(LAS const f32x4*)(bb + (5 * 16 + s) * 64 + q * 8 + 4);
            float sa = (S[0] * a0[0] + S[1] * a0[1]) + (S[2] * a0[2] + S[3] * a0[3]) + (S[4] * a1[0] + S[5] * a1[1]) + (S[6] * a1[2] + S[7] * a1[3]);
            sa = allreduce8(sa);
#pragma unroll
            for (int j = 0; j < 4; ++j) { S[j] = S[j] * d0[j] + sa * b0[j] + vi * k0[j]; S[4 + j] = S[4 + j] * d1[j] + sa * b1[j] + vi * k1[j]; }
            float y = (S[0] * r0[0] + S[1] * r0[1]) + (S[2] * r0[2] + S[3] * r0[3]) + (S[4] * r1[0] + S[5] * r1[1]) + (S[6] * r1[2] + S[7] * r1[3]);
            y = allreduce8(y);
            if (q == 0) Yb[s * 64 + i] = y;
        }
        __syncthreads();
        {
            const int s = tid >> 5, i0 = (tid & 31) * 2;
            if (s < ns) {
                const float y0 = Yb[s * 64 + i0], y1 = Yb[s * 64 + i0 + 1];
                float sm = y0 + y1;
#pragma unroll
                for (int o = 16; o > 0; o >>= 1) sm += __shfl_xor(sm, o);
                const float mean = sm * (1.0f / 64.0f); const float e0 = y0 - mean, e1 = y1 - mean;
                float vr = e0 * e0 + e1 * e1;
#pragma unroll
                for (int o = 16; o > 0; o >>= 1) vr += __shfl_xor(vr, o);
                const float rstd = rsqrtf(vr * (1.0f / 64.0f) + 64e-5f);
                float bs = bb[(0 * 16 + s) * 64 + i0] * bb[(2 * 16 + s) * 64 + i0] * rk[i0] + bb[(0 * 16 + s) * 64 + i0 + 1] * bb[(2 * 16 + s) * 64 + i0 + 1] * rk[i0 + 1];
#pragma unroll
                for (int o = 16; o > 0; o >>= 1) bs += __shfl_xor(bs, o);
                const size_t mrow = (size_t)(m0 + c * 16 + s);
                const f32x2 g = *(const f32x2*)((const float*)(ws + W_G) + mrow * 512 + h * 64 + i0);
                const float o0 = (e0 * rstd * lnw[i0] + lnb[i0] + bs * bb[(3 * 16 + s) * 64 + i0]) * g.x;
                const float o1 = (e1 * rstd * lnw[i0 + 1] + lnb[i0 + 1] + bs * bb[(3 * 16 + s) * 64 + i0 + 1]) * g.y;
                *(unsigned*)((bf16_t*)(ws + W_YCAT) + mrow * 1024 + h * 64 + i0) = cvt_pk_bf16(o0, o1);
            }
        }
        if (c + 1 < nch) lstore(bi ^ 1);
        __syncthreads();
    }
    *(f32x4*)(Sout + i * 64 + q * 8) = (f32x4){S[0], S[1], S[2], S[3]};
    *(f32x4*)(Sout + i * 64 + q * 8 + 4) = (f32x4){S[4], S[5], S[6], S[7]};
}

constexpr int A_KL = 0, A_VL = 9216, A_G = 17920, A_E = A_G + 16384, A_MISC = A_E + 16384;
struct AttnSt { f32x16 o0, o1; float m, l; };
__device__ __forceinline__ void attn_init(AttnSt& s) {
#pragma unroll
    for (int i = 0; i < 16; ++i) { s.o0[i] = 0.f; s.o1[i] = 0.f; }
    s.m = -1e30f; s.l = 0.f;
}
__device__ __forceinline__ int keyl_of(int reg, int h) { return (reg & 3) + 8 * (reg >> 2) + 4 * h; }
__device__ __forceinline__ unsigned range_mask(int base, int h, int lo, int hi) {
    unsigned vm = 0;
#pragma unroll
    for (int reg = 0; reg < 16; ++reg) { const int k = base + keyl_of(reg, h); vm |= (k >= lo && k <= hi) ? (1u << reg) : 0u; }
    return vm;
}
__device__ __forceinline__ f32x16 qk_sub(const LAS bf16_t* Kl, int krow0, const bf16x8 (&Qf)[4], int r, int h) {
    f32x16 s;
#pragma unroll
    for (int i = 0; i < 16; ++i) s[i] = 0.f;
#pragma unroll
    for (int ks = 0; ks < 4; ++ks) { const bf16x8 kf = *(const LAS bf16x8*)(Kl + (krow0 + r) * 72 + ks * 16 + h * 8); s = mfma32(kf, Qf[ks], s); }
    return s;
}
__device__ __forceinline__ void sm_update(f32x16& s, AttnSt& st, unsigned vm) {
    float mx = -1e30f;
#pragma unroll
    for (int reg = 0; reg < 16; ++reg) mx = ((vm >> reg) & 1u) ? fmaxf(mx, s[reg]) : mx;
    mx = fmaxf(mx, __shfl_xor(mx, 32));
    const float mnew = fmaxf(st.m, mx); const float alpha = __expf(st.m - mnew);
    float sum = 0.f;
#pragma unroll
    for (int reg = 0; reg < 16; ++reg) { const float pv = ((vm >> reg) & 1u) ? __expf(s[reg] - mnew) : 0.f; s[reg] = pv; sum += pv; }
    st.l = st.l * alpha + sum; st.m = mnew;
    st.o0 = st.o0 * alpha; st.o1 = st.o1 * alpha;
}
__device__ __forceinline__ void pv_sub(const LAS bf16_t* Vl, int kcol0, const f32x16& pr, AttnSt& st, int r, int h) {
#pragma unroll
    for (int s2 = 0; s2 < 2; ++s2) {
        const bf16x8 pf = pack8(pr[8 * s2 + 0], pr[8 * s2 + 1], pr[8 * s2 + 2], pr[8 * s2 + 3], pr[8 * s2 + 4], pr[8 * s2 + 5], pr[8 * s2 + 6], pr[8 * s2 + 7]);
#pragma unroll
        for (int dt = 0; dt < 2; ++dt) {
            const LAS bf16_t* vp = Vl + (dt * 32 + r) * 68 + kcol0 + 16 * s2 + 4 * h;
            const u32x2 a = *(const LAS u32x2*)vp, b = *(const LAS u32x2*)(vp + 8);
            const bf16x8 vf = __builtin_bit_cast(bf16x8, (u32x4){a.x, a.y, b.x, b.y});
            if (dt == 0) st.o0 = mfma32(vf, pf, st.o0); else st.o1 = mfma32(vf, pf, st.o1);
        }
    }
}
__device__ __forceinline__ void stage_k_bf16(LAS bf16_t* Kl, const bf16_t* Kg, int tid) {
    const int key = tid >> 3, part = tid & 7; const u32x4 v = *(const u32x4*)(Kg + key * 64 + part * 8); *(LAS u32x4*)(Kl + key * 72 + part * 8) = v;
}
__device__ __forceinline__ void stage_vt_bf16(LAS bf16_t* Vl, const bf16_t* Vg, int Tp, int tid) {
    const int dim = tid >> 3, part = tid & 7; const u32x4 v = *(const u32x4*)(Vg + (size_t)dim * Tp + part * 8);
    LAS u32x2* d = (LAS u32x2*)(Vl + dim * 68 + part * 8); d[0] = (u32x2){v.x, v.y}; d[1] = (u32x2){v.z, v.w};
}
__device__ __forceinline__ void stage_kv_f32(LAS bf16_t* Kl, LAS bf16_t* Vl, const float* rowp, int g, int tid) {
    const int key = tid >> 3, part = tid & 7;
    f32x4 k0 = (f32x4){0.f, 0.f, 0.f, 0.f}, k1 = k0, v0 = k0, v1 = k0;
    if (rowp) { const float* s = rowp + g * 64 + part * 8; k0 = *(const f32x4*)s; k1 = *(const f32x4*)(s + 4); v0 = *(const f32x4*)(s + 128); v1 = *(const f32x4*)(s + 132); }
    u32x4 w; w.x = cvt_pk_bf16(k0[0], k0[1]); w.y = cvt_pk_bf16(k0[2], k0[3]); w.z = cvt_pk_bf16(k1[0], k1[1]); w.w = cvt_pk_bf16(k1[2], k1[3]);
    *(LAS u32x4*)(Kl + key * 72 + part * 8) = w;
#pragma unroll
    for (int j = 0; j < 4; ++j) { Vl[(part * 8 + j) * 68 + key] = f2bf(v0[j]); Vl[(part * 8 + 4 + j) * 68 + key] = f2bf(v1[j]); }
}
__device__ __forceinline__ void cmp_stats(const f32x16& s, unsigned vm, float& m1, float& l1) {
    float mx = -1e30f;
#pragma unroll
    for (int reg = 0; reg < 16; ++reg) mx = ((vm >> reg) & 1u) ? fmaxf(mx, s[reg]) : mx;
    mx = fmaxf(mx, __shfl_xor(mx, 32));
    const float mnew = fmaxf(m1, mx); float sum = 0.f;
#pragma unroll
    for (int reg = 0; reg < 16; ++reg) sum += ((vm >> reg) & 1u) ? __expf(s[reg] - mnew) : 0.f;
    l1 = l1 * __expf(m1 - mnew) + sum; m1 = mnew;
}
__device__ __forceinline__ void cmp_probs(f32x16& s, unsigned vm, float m1, float inv, LAS float* Gl, LAS float* El, int tlrow, int jbase, int r, int h) {
#pragma unroll
    for (int reg = 0; reg < 16; ++reg) s[reg] = ((vm >> reg) & 1u) ? __expf(s[reg] - m1) * inv : 0.f;
#pragma unroll
    for (int q4 = 0; q4 < 4; ++q4) {
        const float p0 = allreduce4(s[4 * q4]), p1 = allreduce4(s[4 * q4 + 1]), p2 = allreduce4(s[4 * q4 + 2]), p3 = allreduce4(s[4 * q4 + 3]);
        if ((r & 3) == 0) { const int j = jbase + 2 * q4 + h; Gl[tlrow * 64 + j] = (p0 + p1) + (p2 + p3); El[tlrow * 64 + j] = p3; }
    }
}
__device__ __forceinline__ unsigned long long topk_mask(const LAS float* Gl, const LAS float* El, int tlrow, int cur, int lane) {
    if (cur < 16) return (1ull << (cur + 1)) - 1ull;
    const int j = lane;
    const float imp = Gl[tlrow * 64 + j] + (j > 0 ? El[tlrow * 64 + j - 1] : 0.f);
    int rank = 0;
    for (int jp = 1; jp <= cur - 2; ++jp) { const float v = __int_as_float(__builtin_amdgcn_readlane(__float_as_int(imp), jp)); rank += ((v > imp) || (v == imp && jp < j)) ? 1 : 0; }
    const bool sel = (j >= 1 && j <= cur - 2 && rank < 13) || j == 0 || j == cur || j == cur - 1;
    return __ballot(sel);
}
__device__ __forceinline__ void attn_fold(f32x16& f0, f32x16& f1, const AttnSt& st, float gate, bool normalised) {
    float sc = gate;
    if (!normalised) { const float lt = st.l + __shfl_xor(st.l, 32); sc = lt > 0.f ? gate / lt : 0.f; }
    f0 = f0 + st.o0 * sc; f1 = f1 + st.o1 * sc;
}
__device__ __forceinline__ void attn_store(CParams& p, int m, int head, const f32x16& f0, const f32x16& f1, int h) {
    bf16_t* yo = (bf16_t*)(p.ws + W_YCAT) + (size_t)m * 1024 + 512 + head * 64;
#pragma unroll
    for (int dt = 0; dt < 2; ++dt)
#pragma unroll
        for (int q4 = 0; q4 < 4; ++q4) {
            f32x4 v;
#pragma unroll
            for (int j = 0; j < 4; ++j) { const int reg = 4 * q4 + j; v[j] = dt == 0 ? f0[reg] : f1[reg]; }
            *(u32x2*)(yo + dt * 32 + 8 * q4 + 4 * h) = pack4(v);
        }
}

__device__ __forceinline__ void attn_prompt_tile(CParams& p, LAS unsigned char* lds, int item) {
    unsigned char* ws = p.ws;
    const int tid = opaque_tid(), wv = __builtin_amdgcn_readfirstlane(tid >> 6), lane = tid & 63, r = lane & 31, h = lane >> 5;
    const int T = 63 - (item >> 3), bg = item & 7, b = bg >> 1, g = bg & 1;
    const int tl = wv * 8 + (r >> 2), head = g * 4 + (r & 3);
    const int pos = 64 * T + tl, m = b * 4096 + pos;
    LAS bf16_t* Kl = (LAS bf16_t*)(lds + A_KL); LAS bf16_t* Vl = (LAS bf16_t*)(lds + A_VL); LAS float* Gl = (LAS float*)(lds + A_G); LAS float* El = (LAS float*)(lds + A_E);
    __syncthreads();
    for (int i = tid; i < 8192; i += NTHR) Gl[i] = 0.f;
    bf16x8 Qf[4];
#pragma unroll
    for (int ks = 0; ks < 4; ++ks) Qf[ks] = *(const bf16x8*)((const bf16_t*)(ws + W_QC) + (size_t)m * 512 + head * 64 + ks * 16 + h * 8);
    const int climit = pos >= 31 ? ((pos - 31) >> 4) : -1;
    const int nct = (4 * T + 3 + 63) >> 6;
    const bf16_t* Kc = (const bf16_t*)(ws + W_KCP) + (size_t)bg * 256 * 64; const bf16_t* Vc = (const bf16_t*)(ws + W_VCPT) + (size_t)bg * 64 * 256;
    float m1 = -1e30f, l1 = 0.f;
    for (int tile = 0; tile < nct; ++tile) {
        __syncthreads(); stage_k_bf16(Kl, Kc + (size_t)tile * 64 * 64, tid); __syncthreads();
#pragma unroll
        for (int sub = 0; sub < 2; ++sub) { const f32x16 s = qk_sub(Kl, sub * 32, Qf, r, h); cmp_stats(s, range_mask(tile * 64 + sub * 32, h, 0, climit), m1, l1); }
    }
    const float l1t = l1 + __shfl_xor(l1, 32); const float inv1 = l1t > 0.f ? 1.0f / l1t : 0.f;
    const float* gn = (const float*)(ws + W_GN) + (size_t)m * 24 + head * 3;
    const float gt0 = gn[0], gt1 = gn[1], gt2 = gn[2];
    f32x16 fin0, fin1;
#pragma unroll
    for (int i = 0; i < 16; ++i) { fin0[i] = 0.f; fin1[i] = 0.f; }
    AttnSt oc; attn_init(oc);
    for (int tile = 0; tile < nct; ++tile) {
        __syncthreads(); stage_k_bf16(Kl, Kc + (size_t)tile * 64 * 64, tid); stage_vt_bf16(Vl, Vc + tile * 64, 256, tid); __syncthreads();
#pragma unroll
        for (int sub = 0; sub < 2; ++sub) {
            f32x16 s = qk_sub(Kl, sub * 32, Qf, r, h);
            cmp_probs(s, range_mask(tile * 64 + sub * 32, h, 0, climit), m1, inv1, Gl, El, tl, tile * 16 + sub * 8, r, h);
            pv_sub(Vl, sub * 32, s, oc, r, h);
        }
    }
    attn_fold(fin0, fin1, oc, gt0, true);
    __syncthreads();
    unsigned long long mymask = 0ull, anymask = 0ull;
    for (int k = 0; k < 8; ++k) { const unsigned long long mk = topk_mask(Gl, El, wv * 8 + k, T, lane); anymask |= mk; if ((r >> 2) == k) mymask = mk; }
#pragma unroll
    for (int ks = 0; ks < 4; ++ks) Qf[ks] = *(const bf16x8*)((const bf16_t*)(ws + W_QR) + (size_t)m * 512 + head * 64 + ks * 16 + h * 8);
    attn_init(oc);
    {
        const bf16_t* Kg = (const bf16_t*)(ws + W_KS) + (size_t)bg * 4096 * 64; const bf16_t* Vg = (const bf16_t*)(ws + W_VST) + (size_t)bg * 64 * 4096;
        for (int j = 0; j <= T; ++j) {
            __syncthreads(); stage_k_bf16(Kl, Kg + (size_t)j * 64 * 64, tid); stage_vt_bf16(Vl, Vg + j * 64, 4096, tid); __syncthreads();
            if ((anymask >> j) & 1ull) {
                const bool en = (mymask >> j) & 1ull;
#pragma unroll
                for (int sub = 0; sub < 2; ++sub) {
                    const unsigned vm = en ? range_mask(j * 64 + sub * 32, h, -1, pos) : 0u;
                    if (__ballot(vm != 0u) == 0ull) continue;
                    f32x16 s = qk_sub(Kl, sub * 32, Qf, r, h); sm_update(s, oc, vm); pv_sub(Vl, sub * 32, s, oc, r, h);
                }
            }
        }
    }
    attn_fold(fin0, fin1, oc, gt1, false);
    attn_init(oc);
    {
        const bf16_t* Kg = (const bf16_t*)(ws + W_KW) + (size_t)bg * 4096 * 64; const bf16_t* Vg = (const bf16_t*)(ws + W_VWT) + (size_t)bg * 64 * 4096;
        for (int j = (T > 8 ? T - 8 : 0); j <= T; ++j) {
            __syncthreads(); stage_k_bf16(Kl, Kg + (size_t)j * 64 * 64, tid); stage_vt_bf16(Vl, Vg + j * 64, 4096, tid); __syncthreads();
#pragma unroll
            for (int sub = 0; sub < 2; ++sub) {
                const unsigned vm = range_mask(j * 64 + sub * 32, h, pos - 511, pos);
                if (__ballot(vm != 0u) == 0ull) continue;
                f32x16 s = qk_sub(Kl, sub * 32, Qf, r, h); sm_update(s, oc, vm); pv_sub(Vl, sub * 32, s, oc, r, h);
            }
        }
    }
    attn_fold(fin0, fin1, oc, gt2, false);
    attn_store(p, m, head, fin0, fin1, h);
}

__device__ __forceinline__ void attn_sample_unit(CParams& p, LAS unsigned char* lds, int unit) {
    unsigned char* ws = p.ws;
    const int tid = opaque_tid(), wv = __builtin_amdgcn_readfirstlane(tid >> 6), lane = tid & 63, r = lane & 31, h = lane >> 5;
    const int seq = unit >> 1, g = unit & 1; const bool act = (wv == 0);
    const int tq = r >> 2, head = g * 4 + (r & 3), pos = 2048 + tq, m = NPT + seq * 8 + tq;
    LAS bf16_t* Kl = (LAS bf16_t*)(lds + A_KL); LAS bf16_t* Vl = (LAS bf16_t*)(lds + A_VL); LAS float* Gl = (LAS float*)(lds + A_G); LAS float* El = (LAS float*)(lds + A_E);
    LAS unsigned* misc = (LAS unsigned*)(lds + A_MISC);
    __syncthreads();
    for (int i = tid; i < 8192; i += NTHR) Gl[i] = 0.f;
    bf16x8 Qf[4];
#pragma unroll
    for (int ks = 0; ks < 4; ++ks) Qf[ks] = *(const bf16x8*)((const bf16_t*)(ws + W_QC) + (size_t)m * 512 + head * 64 + ks * 16 + h * 8);
    const bf16_t* Kc = (const bf16_t*)(ws + W_KCS) + (size_t)unit * 128 * 64; const bf16_t* Vc = (const bf16_t*)(ws + W_VCST) + (size_t)unit * 64 * 128;
    float m1 = -1e30f, l1 = 0.f;
    for (int tile = 0; tile < 2; ++tile) {
        __syncthreads(); stage_k_bf16(Kl, Kc + (size_t)tile * 64 * 64, tid); __syncthreads();
        if (act) {
#pragma unroll
            for (int sub = 0; sub < 2; ++sub) { const f32x16 s = qk_sub(Kl, sub * 32, Qf, r, h); cmp_stats(s, range_mask(tile * 64 + sub * 32, h, 0, 126), m1, l1); }
        }
    }
    const float l1t = l1 + __shfl_xor(l1, 32); const float inv1 = l1t > 0.f ? 1.0f / l1t : 0.f;
    const float* gn = (const float*)(ws + W_GN) + (size_t)m * 24 + head * 3;
    const float gt0 = gn[0], gt1 = gn[1], gt2 = gn[2];
    f32x16 fin0, fin1;
#pragma unroll
    for (int i = 0; i < 16; ++i) { fin0[i] = 0.f; fin1[i] = 0.f; }
    AttnSt oc; attn_init(oc);
    for (int tile = 0; tile < 2; ++tile) {
        __syncthreads(); stage_k_bf16(Kl, Kc + (size_t)tile * 64 * 64, tid); stage_vt_bf16(Vl, Vc + tile * 64, 128, tid); __syncthreads();
        if (act) {
#pragma unroll
            for (int sub = 0; sub < 2; ++sub) {
                f32x16 s = qk_sub(Kl, sub * 32, Qf, r, h);
                cmp_probs(s, range_mask(tile * 64 + sub * 32, h, 0, 126), m1, inv1, Gl, El, tq, tile * 16 + sub * 8, r, h);
                pv_sub(Vl, sub * 32, s, oc, r, h);
            }
        }
    }
    attn_fold(fin0, fin1, oc, gt0, true);
    __syncthreads();
    unsigned long long mymask = 0ull, anymask = 0ull;
    if (act) {
        for (int k = 0; k < 8; ++k) { const unsigned long long mk = topk_mask(Gl, El, k, 32, lane); anymask |= mk; if (tq == k) mymask = mk; }
        if (lane == 0) { misc[0] = (unsigned)anymask; misc[1] = (unsigned)(anymask >> 32); }
    }
    __syncthreads();
    anymask = (unsigned long long)misc[0] | ((unsigned long long)misc[1] << 32);
#pragma unroll
    for (int ks = 0; ks < 4; ++ks) Qf[ks] = *(const bf16x8*)((const bf16_t*)(ws + W_QR) + (size_t)m * 512 + head * 64 + ks * 16 + h * 8);
    const int* pt = (const int*)p.in[7] + seq * 16;
    const int key = tid >> 3;
    attn_init(oc);
    for (int j = 0; j <= 32; ++j) {
        if (!((anymask >> j) & 1ull)) continue;
        const float* rowp;
        if (j < 32) rowp = p.in[3] + ((size_t)pt[j >> 1] * 128 + (j & 1) * 64 + key) * 256;
        else rowp = key < 8 ? p.out + O_SSLC + ((size_t)seq * 8 + key) * 256 : nullptr;
        __syncthreads(); stage_kv_f32(Kl, Vl, rowp, g, tid); __syncthreads();
        if (act) {
            const bool en = (mymask >> j) & 1ull;
#pragma unroll
            for (int sub = 0; sub < 2; ++sub) {
                const unsigned vm = en ? range_mask(j * 64 + sub * 32, h, -1, pos) : 0u;
                if (__ballot(vm != 0u) == 0ull) continue;
                f32x16 s = qk_sub(Kl, sub * 32, Qf, r, h); sm_update(s, oc, vm); pv_sub(Vl, sub * 32, s, oc, r, h);
            }
        }
    }
    attn_fold(fin0, fin1, oc, gt1, false);
    attn_init(oc);
    for (int wt = 0; wt < 9; ++wt) {
        const int idx = wt * 64 + key;
        const float* rowp = idx < 512 ? p.in[4] + ((size_t)seq * 512 + idx) * 256 : (idx < 520 ? p.out + O_SWIN + ((size_t)seq * 512 + 504 + (idx - 512)) * 256 : nullptr);
        __syncthreads(); stage_kv_f32(Kl, Vl, rowp, g, tid); __syncthreads();
        if (act) {
#pragma unroll
            for (int sub = 0; sub < 2; ++sub) {
                const unsigned vm = range_mask(wt * 64 + sub * 32, h, tq + 1, 512 + tq);
                if (__ballot(vm != 0u) == 0ull) continue;
                f32x16 s = qk_sub(Kl, sub * 32, Qf, r, h); sm_update(s, oc, vm); pv_sub(Vl, sub * 32, s, oc, r, h);
            }
        }
    }
    attn_fold(fin0, fin1, oc, gt2, false);
    if (act) attn_store(p, m, head, fin0, fin1, h);
}

__device__ __forceinline__ void phase3(LAS unsigned char* lds, int bid, int nb) {
    CParams& p = kparams();
    LAS unsigned* slot = (LAS unsigned*)(lds + LDS_BYTES - 64);
    unsigned* ctr = (unsigned*)(p.ws + W_CTR);
    for (;;) {
        __syncthreads();
        if (threadIdx.x == 0) *slot = atomicAdd(ctr, 1u);
        __syncthreads();
        const int item = __builtin_amdgcn_readfirstlane((int)*slot);
        if (item >= 1824) break;
        if (item < 32) scan_unit(p, lds, item);
        else if (item < 544) attn_prompt_tile(p, lds, item - 32);
        else if (item < 800) attn_sample_unit(p, lds, item - 544);
        else scan_unit(p, lds, 32 + (item - 800));
    }
}

struct EpiG3 {
    static constexpr bool AFTER_DRAIN = false, HAS_MID = true; static constexpr int MID_T = 8;
    unsigned char* ws;
    __device__ __forceinline__ void mid(f32x4 (&acc)[2][2][4][2], const Unit& u, int wr, int wc, int fr, int fq) const {
#pragma unroll
        for (int ai = 0; ai < 2; ++ai)
#pragma unroll
            for (int m = 0; m < 4; ++m) { const size_t row = (size_t)u.pm * 256 + ai * 128 + wr * 64 + m * 16 + fr; const bf16_t* gp = (const bf16_t*)(ws + W_GATES) + row * 2048;
#pragma unroll
                for (int bj = 0; bj < 2; ++bj)
#pragma unroll
                    for (int n = 0; n < 2; ++n) { const int col = u.pn * 256 + bj * 128 + wc * 32 + n * 16 + fq * 4; const f32x4 sr = ld_bf4(gp + col), sn = ld_bf4(gp + 1024 + col);
#pragma unroll
                        for (int j = 0; j < 4; ++j) acc[ai][bj][m][n][j] *= sr[j] / fmaxf(sn[j], 1e-30f); } }
    }
    __device__ __forceinline__ void operator()(const f32x4 (&acc)[2][2][4][2], const Unit& u, int wr, int wc, int fr, int fq) const {
#pragma unroll
        for (int ai = 0; ai < 2; ++ai)
#pragma unroll
            for (int m = 0; m < 4; ++m) { const size_t row = (size_t)u.pm * 256 + ai * 128 + wr * 64 + m * 16 + fr; const bf16_t* gp = (const bf16_t*)(ws + W_GATES) + row * 2048;
#pragma unroll
                for (int bj = 0; bj < 2; ++bj)
#pragma unroll
                    for (int n = 0; n < 2; ++n) { const int col = u.pn * 256 + bj * 128 + wc * 32 + n * 16 + fq * 4; const f32x4 sn = ld_bf4(gp + 1024 + col);
                        f32x4 v = acc[ai][bj][m][n];
#pragma unroll
                        for (int j = 0; j < 4; ++j) v[j] *= fmaxf(sn[j], 1e-30f);
                        *(u32x2*)((bf16_t*)(ws + W_MERGED) + row * 1024 + col) = pack4(v); } }
    }
};
struct EpiG4 {
    static constexpr bool AFTER_DRAIN = false, HAS_MID = false; static constexpr int MID_T = 0;
    unsigned char* ws; const float* xp; const float* xs; const float* gffn;
    __device__ __forceinline__ void mid(f32x4 (&)[2][2][4][2], const Unit&, int, int, int, int) const {}
    __device__ __forceinline__ void operator()(const f32x4 (&acc)[2][2][4][2], const Unit& u, int wr, int wc, int fr, int fq) const {
#pragma unroll
        for (int ai = 0; ai < 2; ++ai)
#pragma unroll
            for (int m = 0; m < 4; ++m) { const size_t row = (size_t)u.pm * 256 + ai * 128 + wr * 64 + m * 16 + fr;
                const float* xr = row < NPT ? xp + row * 1024 : xs + (row - NPT) * 1024; float ss = 0.f;
#pragma unroll
                for (int bj = 0; bj < 2; ++bj)
#pragma unroll
                    for (int n = 0; n < 2; ++n) { const int col = u.pn * 256 + bj * 128 + wc * 32 + n * 16 + fq * 4;
                        const f32x4 x2 = *(const f32x4*)(xr + col) + acc[ai][bj][m][n]; const f32x4 gf = *(const f32x4*)(gffn + col);
                        ss += x2[0] * x2[0] + x2[1] * x2[1] + x2[2] * x2[2] + x2[3] * x2[3];
                        *(f32x4*)((float*)(ws + W_X2) + row * 1024 + col) = x2;
                        *(u32x2*)((bf16_t*)(ws + W_A2) + row * 1024 + col) = pack4(x2 * gf); }
                ss += __shfl_xor(ss, 16); ss += __shfl_xor(ss, 32);
                if (fq == 0) atomicAdd((float*)(ws + W_RS1) + row, ss); }
    }
};
struct EpiG5 {
    static constexpr bool AFTER_DRAIN = false, HAS_MID = false; static constexpr int MID_T = 0;
    unsigned char* ws;
    __device__ __forceinline__ void mid(f32x4 (&)[2][2][4][2], const Unit&, int, int, int, int) const {}
    __device__ __forceinline__ void operator()(const f32x4 (&acc)[2][2][4][2], const Unit& u, int wr, int wc, int fr, int fq) const {
#pragma unroll
        for (int ai = 0; ai < 2; ++ai)
#pragma unroll
            for (int m = 0; m < 4; ++m) { const size_t row = (size_t)u.pm * 256 + ai * 128 + wr * 64 + m * 16 + fr;
                const float rs = rsqrtf(((const float*)(ws + W_RS1))[row] * (1.0f / 1024.0f) + 1e-6f);
#pragma unroll
                for (int n = 0; n < 2; ++n) { const int col = u.pn * 128 + wc * 32 + n * 16 + fq * 4; f32x4 a;
#pragma unroll
                    for (int j = 0; j < 4; ++j) { const float gt = acc[ai][0][m][n][j] * rs, up = acc[ai][1][m][n][j] * rs; a[j] = gt * sigmoidf_(gt) * up; }
                    *(u32x2*)((bf16_t*)(ws + W_ACT) + row * 2816 + col) = pack4(a); } }
    }
};
struct EpiG6 {
    static constexpr bool AFTER_DRAIN = false, HAS_MID = false; static constexpr int MID_T = 0;
    unsigned char* ws;
    __device__ __forceinline__ void mid(f32x4 (&)[2][2][4][2], const Unit&, int, int, int, int) const {}
    __device__ __forceinline__ void operator()(const f32x4 (&acc)[2][2][4][2], const Unit& u, int wr, int wc, int fr, int fq) const {
#pragma unroll
        for (int ai = 0; ai < 2; ++ai)
#pragma unroll
            for (int m = 0; m < 4; ++m) { const size_t row = (size_t)u.pm * 256 + ai * 128 + wr * 64 + m * 16 + fr; float ss = 0.f;
#pragma unroll
                for (int bj = 0; bj < 2; ++bj)
#pragma unroll
                    for (int n = 0; n < 2; ++n) { const int col = u.pn * 256 + bj * 128 + wc * 32 + n * 16 + fq * 4;
                        const f32x4 x3 = *(const f32x4*)((const float*)(ws + W_X2) + row * 1024 + col) + acc[ai][bj][m][n];
                        ss += x3[0] * x3[0] + x3[1] * x3[1] + x3[2] * x3[2] + x3[3] * x3[3];
                        *(f32x4*)((float*)(ws + W_X3) + row * 1024 + col) = x3; }
                ss += __shfl_xor(ss, 16); ss += __shfl_xor(ss, 32);
                if (fq == 0) atomicAdd((float*)(ws + W_RS2) + row, ss); }
    }
};
__device__ __forceinline__ void phase4(LAS unsigned char* lds, int bid, int nb) {
    CParams& p = kparams();
    pg8::Gemm g{(const bf16_t*)(p.ws + W_YCAT), (const bf16_t*)(p.ws + W_BTM), NTOK, 1024, 1024};
    pg8::StaticOrder S; S.init(NTOK, 1024, nb, bid); EpiG3 E{p.ws}; pg8::gemm_phase(lds, g, S, E);
}
__device__ __forceinline__ void phase5(LAS unsigned char* lds, int bid, int nb) {
    CParams& p = kparams();
    pg8::Gemm g{(const bf16_t*)(p.ws + W_MERGED), (const bf16_t*)(p.ws + W_BTO), NTOK, 1024, 1024};
    pg8::StaticOrder S; S.init(NTOK, 1024, nb, bid); EpiG4 E{p.ws, p.in[0], p.in[1], p.in[27]}; pg8::gemm_phase(lds, g, S, E);
}
__device__ __forceinline__ void phase6(LAS unsigned char* lds, int bid, int nb) {
    CParams& p = kparams();
    pg8::Gemm g{(const bf16_t*)(p.ws + W_A2), (const bf16_t*)(p.ws + W_BTGU), NTOK, 5632, 1024};
    pg8::StaticOrder S; S.init(NTOK, 5632, nb, bid); EpiG5 E{p.ws}; pg8::gemm_phase(lds, g, S, E);
}
__device__ __forceinline__ void phase7(LAS unsigned char* lds, int bid, int nb) {
    CParams& p = kparams();
    pg8::Gemm g{(const bf16_t*)(p.ws + W_ACT), (const bf16_t*)(p.ws + W_BTD), NTOK, 1024, 2816};
    pg8::StaticOrder S; S.init(NTOK, 1024, nb, bid); EpiG6 E{p.ws}; pg8::gemm_phase(lds, g, S, E);
}
__device__ __forceinline__ void phase8(int bid, int nb) {
    CParams& p = kparams();
    const size_t gtid = (size_t)bid * NTHR + threadIdx.x, gsz = (size_t)nb * NTHR;
    const float* x3 = (const float*)(p.ws + W_X3); const float* rs2 = (const float*)(p.ws + W_RS2); const float* gf = p.in[31];
    for (size_t i = gtid; i < (size_t)NTOK * 256; i += gsz) {
        const size_t row = i >> 8; const int c4 = (int)(i & 255) * 4;
        const float rs = rsqrtf(rs2[row] * (1.0f / 1024.0f) + 1e-6f);
        const f32x4 v = *(const f32x4*)(x3 + row * 1024 + c4) * rs * *(const f32x4*)(gf + c4);
        *(f32x4*)(p.out + row * 1024 + c4) = v;
    }
}

extern __shared__ __attribute__((aligned(16))) unsigned char smem_raw[];

__global__ __launch_bounds__(512) void fwd_kernel(Params p) {
    cg::grid_group grid = cg::this_grid();
    LAS unsigned char* lds = (LAS unsigned char*)smem_raw;
    const int bid = blockIdx.x, nb = gridDim.x;
#define RUN_PHASE(k, call) if (p.ph_lo <= (k) && (k) < p.ph_hi) { if ((k) > p.ph_lo) grid.sync(); call; }
    RUN_PHASE(0, phase0(bid, nb));
    RUN_PHASE(1, phase1(lds, bid, nb));
    RUN_PHASE(2, phase2(lds, bid, nb));
    RUN_PHASE(3, phase3(lds, bid, nb));
    RUN_PHASE(4, phase4(lds, bid, nb));
    RUN_PHASE(5, phase5(lds, bid, nb));
    RUN_PHASE(6, phase6(lds, bid, nb));
    RUN_PHASE(7, phase7(lds, bid, nb));
    RUN_PHASE(8, phase8(bid, nb));
#undef RUN_PHASE
}

#ifndef N_LAUNCH_SPLIT
#define N_LAUNCH_SPLIT 1
#endif
constexpr int NPHASE = 9;

extern "C" void kernel_launch(void* const* d_in, const int* in_sizes, int n_in, void* d_out, int out_size, void* d_ws, size_t ws_size, hipStream_t stream) {
    static int grid_blocks = 0;
    if (!grid_blocks) {
        int dev = 0, cus = 0, per_cu = 0;
        hipGetDevice(&dev);
        hipDeviceGetAttribute(&cus, hipDeviceAttributeMultiprocessorCount, dev);
        hipFuncSetAttribute((const void*)fwd_kernel, hipFuncAttributeMaxDynamicSharedMemorySize, LDS_BYTES);
        hipOccupancyMaxActiveBlocksPerMultiprocessor(&per_cu, (const void*)fwd_kernel, NTHR, LDS_BYTES);
        if (per_cu < 1) per_cu = 1;
        if (per_cu > 1) per_cu = 1;
        grid_blocks = cus * per_cu;
        if (ws_size < W_END) fprintf(stderr, "workspace too small: %zu < %zu\n", ws_size, (size_t)W_END);
    }
    Params p{};
    for (int i = 0; i < 32; ++i) p.in[i] = (const float*)d_in[i];
    p.out = (float*)d_out; p.ws = (unsigned char*)d_ws;
#if N_LAUNCH_SPLIT
    for (int ph = 0; ph < NPHASE; ++ph) {
        p.ph_lo = ph; p.ph_hi = ph + 1;
        hipLaunchKernelGGL(fwd_kernel, dim3(grid_blocks), dim3(NTHR), LDS_BYTES, stream, p);
    }
#else
    p.ph_lo = 0; p.ph_hi = NPHASE;
    void* args[] = {&p};
    hipError_t e = hipLaunchCooperativeKernel((const void*)fwd_kernel, dim3(grid_blocks), dim3(NTHR), args, LDS_BYTES, stream);
    if (e != hipSuccess) fprintf(stderr, "cooperative launch failed: %s (grid %d)\n", hipGetErrorString(e), grid_blocks);
#endif
}
```

```cpp
#include <hip/hip_runtime.h>
#include <hip/hip_cooperative_groups.h>
#include <cstdio>
#include <cstdint>
namespace cg = cooperative_groups;

#define LAS __attribute__((address_space(3)))
typedef unsigned short bf16_t;
typedef short bf16x8 __attribute__((ext_vector_type(8)));
typedef short bf16x4 __attribute__((ext_vector_type(4)));
typedef float f32x2 __attribute__((ext_vector_type(2)));
typedef float f32x4 __attribute__((ext_vector_type(4)));
typedef float f32x8 __attribute__((ext_vector_type(8)));
typedef float f32x16 __attribute__((ext_vector_type(16)));
typedef unsigned u32x2 __attribute__((ext_vector_type(2)));
typedef unsigned u32x4 __attribute__((ext_vector_type(4)));

constexpr int NTOK = 17408, NPT = 16384, TP = 4096;
constexpr int LDS_BYTES = 147456;
constexpr int NTHR = 512;

constexpr size_t O_YP = 0;
constexpr size_t O_YS = O_YP + 16777216;
constexpr size_t O_PCMP = O_YS + 1048576;
constexpr size_t O_PSLC = O_PCMP + 4194304;
constexpr size_t O_PWIN = O_PSLC + 4194304;
constexpr size_t O_PRWKV = O_PWIN + 524288;
constexpr size_t O_PSHIFT = O_PRWKV + 131072;
constexpr size_t O_SCMP = O_PSHIFT + 7296;
constexpr size_t O_SSLC = O_SCMP + 262144;
constexpr size_t O_SWIN = O_SSLC + 262144;
constexpr size_t O_SRWKV = O_SWIN + 16777216;
constexpr size_t O_SSHIFT = O_SRWKV + 4194304;

constexpr size_t AL(size_t x) { return (x + 255) & ~(size_t)255; }
constexpr size_t W_BT1 = 0;
constexpr size_t W_BTM = W_BT1 + AL(5376ull * 1024 * 2);
constexpr size_t W_BTO = W_BTM + AL(1024ull * 1024 * 2);
constexpr size_t W_BTGU = W_BTO + AL(1024ull * 1024 * 2);
constexpr size_t W_BTD = W_BTGU + AL(5632ull * 1024 * 2);
constexpr size_t W_BTC1 = W_BTD + AL(1024ull * 2816 * 2);
constexpr size_t W_BTC2 = W_BTC1 + AL(2ull * 256 * 1024 * 2);
constexpr size_t W_BIASC = W_BTC2 + AL(2ull * 64 * 128 * 2);
constexpr size_t W_BTDEC = W_BIASC + AL(2 * 256 * 4);
constexpr size_t W_BTAAA = W_BTDEC + AL(512 * 64 * 2);
constexpr size_t W_BTGATE = W_BTAAA + AL(512 * 64 * 2);
constexpr size_t W_ROPE = W_BTGATE + AL(512 * 160 * 2);
constexpr size_t W_H = W_ROPE + AL(4096 * 16 * 4);
constexpr size_t W_P = W_H + AL((size_t)NTOK * 1024 * 2);
constexpr size_t W_QC = W_P + AL((size_t)NTOK * 1824 * 2);
constexpr size_t W_QR = W_QC + AL((size_t)NTOK * 512 * 2);
constexpr size_t W_CPM = W_QR + AL((size_t)NTOK * 512 * 2);
constexpr size_t W_CSM = W_CPM + AL(2ull * 2048 * 1024 * 2);
constexpr size_t W_KS = W_CSM + AL(2ull * 32768 * 1024 * 2);
constexpr size_t W_VST = W_KS + AL(8ull * 4096 * 64 * 2);
constexpr size_t W_KW = W_VST + AL(8ull * 4096 * 64 * 2);
constexpr size_t W_VWT = W_KW + AL(8ull * 4096 * 64 * 2);
constexpr size_t W_KCP = W_VWT + AL(8ull * 4096 * 64 * 2);
constexpr size_t W_VCPT = W_KCP + AL(8ull * 256 * 64 * 2);
constexpr size_t W_KCS = W_VCPT + AL(8ull * 256 * 64 * 2);
constexpr size_t W_VCST = W_KCS + AL(256ull * 128 * 64 * 2);
constexpr size_t W_GATES = W_VCST + AL(256ull * 128 * 64 * 2);
constexpr size_t W_GN = W_GATES + AL((size_t)NTOK * 2048 * 2);
constexpr size_t W_R = W_GN + AL((size_t)NTOK * 24 * 4);
constexpr size_t RW_SZ = AL((size_t)NTOK * 512 * 4);
constexpr size_t W_DEC = W_R + RW_SZ;
constexpr size_t W_KH = W_DEC + RW_SZ;
constexpr size_t W_V = W_KH + RW_SZ;
constexpr size_t W_AV = W_V + RW_SZ;
constexpr size_t W_BV = W_AV + RW_SZ;
constexpr size_t W_G = W_BV + RW_SZ;
constexpr size_t W_YCAT = W_G + RW_SZ;
constexpr size_t W_MERGED = W_YCAT + AL((size_t)NTOK * 1024 * 2);
constexpr size_t W_X2 = W_MERGED + AL((size_t)NTOK * 1024 * 2);
constexpr size_t W_A2 = W_X2 + AL((size_t)NTOK * 1024 * 4);
constexpr size_t W_ACT = W_A2 + AL((size_t)NTOK * 1024 * 2);
constexpr size_t W_X3 = W_ACT + AL((size_t)NTOK * 2816 * 2);
constexpr size_t W_RS1 = W_X3 + AL((size_t)NTOK * 1024 * 4);
constexpr size_t W_RS2 = W_RS1 + AL((size_t)NTOK * 4);
constexpr size_t W_CTR = W_RS2 + AL((size_t)NTOK * 4);
constexpr size_t W_YRAW = W_CTR + 256;
constexpr size_t W_BON = W_YRAW + RW_SZ;
constexpr size_t W_COP = W_BON + AL((size_t)NTOK * 8 * 4);
constexpr size_t W_BAR = W_COP + 32ull * 256 * 18432;
constexpr size_t W_BAR_BYTES = 3456 * 4 + 256;
constexpr size_t W_END = W_BAR + AL(W_BAR_BYTES);

struct Params { const float* in[32]; float* out; unsigned char* ws; int ph_lo, ph_hi; };

typedef const __attribute__((address_space(4))) Params CParams;
__device__ __forceinline__ CParams& kparams() {
    CParams* kp = (CParams*)__builtin_amdgcn_kernarg_segment_ptr();
    asm volatile("" : "+s"(kp));
    return *kp;
}
__device__ __forceinline__ int opaque_tid() { int t = threadIdx.x; asm volatile("" : "+v"(t)); return t; }
typedef _Float16 h16x2 __attribute__((ext_vector_type(2)));
typedef _Float16 h16x8 __attribute__((ext_vector_type(8)));
__device__ __forceinline__ unsigned cvt_pk_bf16(float lo, float hi) { h16x2 v; v[0] = (_Float16)lo; v[1] = (_Float16)hi; return __builtin_bit_cast(unsigned, v); }
__device__ __forceinline__ float bf_lo(unsigned u) { const h16x2 v = __builtin_bit_cast(h16x2, u); return (float)v[0]; }
__device__ __forceinline__ float bf_hi(unsigned u) { const h16x2 v = __builtin_bit_cast(h16x2, u); return (float)v[1]; }
__device__ __forceinline__ float bf2f(bf16_t b) { return (float)__builtin_bit_cast(_Float16, b); }
__device__ __forceinline__ bf16_t f2bf(float f) { return __builtin_bit_cast(bf16_t, (_Float16)f); }
__device__ __forceinline__ u32x2 pack4(f32x4 v) { u32x2 r; r.x = cvt_pk_bf16(v[0], v[1]); r.y = cvt_pk_bf16(v[2], v[3]); return r; }
__device__ __forceinline__ u32x4 widen16(u32x2 a, u32x2 b) {
    const auto r0 = __builtin_amdgcn_permlane16_swap(a.x, b.x, false, false);
    const auto r1 = __builtin_amdgcn_permlane16_swap(a.y, b.y, false, false);
    return (u32x4){r0[0], r1[0], r0[1], r1[1]};
}
__device__ __forceinline__ int col8_of(int fq) { return ((fq & 1) << 4) | ((fq >> 1) << 3); }
__device__ __forceinline__ bf16x8 pack8(float a0, float a1, float a2, float a3, float a4, float a5, float a6, float a7) {
    u32x4 r; r.x = cvt_pk_bf16(a0, a1); r.y = cvt_pk_bf16(a2, a3); r.z = cvt_pk_bf16(a4, a5); r.w = cvt_pk_bf16(a6, a7);
    return __builtin_bit_cast(bf16x8, r);
}
__device__ __forceinline__ f32x8 ld_bf8(const bf16_t* p) {
    const u32x4 v = *(const u32x4*)p; f32x8 o;
    o[0] = bf_lo(v.x); o[1] = bf_hi(v.x); o[2] = bf_lo(v.y); o[3] = bf_hi(v.y); o[4] = bf_lo(v.z); o[5] = bf_hi(v.z); o[6] = bf_lo(v.w); o[7] = bf_hi(v.w); return o;
}
__device__ __forceinline__ f32x4 ld_bf4(const bf16_t* p) {
    const u32x2 v = *(const u32x2*)p; f32x4 o; o[0] = bf_lo(v.x); o[1] = bf_hi(v.x); o[2] = bf_lo(v.y); o[3] = bf_hi(v.y); return o;
}
__device__ __forceinline__ float sigmoidf_(float x) { return __builtin_amdgcn_rcpf(1.0f + __expf(-x)); }
__device__ __forceinline__ float tanhf_(float x) { return 1.0f - 2.0f * __builtin_amdgcn_rcpf(__expf(2.0f * x) + 1.0f); }
__device__ __forceinline__ float dppf(float x, const int ctrl_sel) {
    const int xi = __float_as_int(x); int r;
    if (ctrl_sel == 0) r = __builtin_amdgcn_update_dpp(0, xi, 0xB1, 0xF, 0xF, false);
    else if (ctrl_sel == 1) r = __builtin_amdgcn_update_dpp(0, xi, 0x4E, 0xF, 0xF, false);
    else r = __builtin_amdgcn_update_dpp(0, xi, 0x141, 0xF, 0xF, false);
    return __int_as_float(r);
}
__device__ __forceinline__ float allreduce4(float x) { x += dppf(x, 0); x += dppf(x, 1); return x; }
__device__ __forceinline__ float allreduce8(float x) { x += dppf(x, 0); x += dppf(x, 1); x += dppf(x, 2); return x; }
__device__ __forceinline__ f32x4 mfma16(bf16x8 a, bf16x8 b, f32x4 c) { return __builtin_amdgcn_mfma_f32_16x16x32_f16(__builtin_bit_cast(h16x8, a), __builtin_bit_cast(h16x8, b), c, 0, 0, 0); }
__device__ __forceinline__ f32x16 mfma32(bf16x8 a, bf16x8 b, f32x16 c) { return __builtin_amdgcn_mfma_f32_32x32x16_f16(__builtin_bit_cast(h16x8, a), __builtin_bit_cast(h16x8, b), c, 0, 0, 0); }

namespace pg8 {
constexpr int BM = 256, BK = 64, HALF = 128, HTB = HALF * BK * 2, STAGE_BYTES = 8 * HTB, NXCD = 8, WGM = 8;
__host__ __device__ __forceinline__ int lds_byte(int r, int c) { const int st = (r >> 4) * 2 + (c >> 5), rr = r & 15, cc = c & 31, ob = rr * 64 + cc * 2; return st * 1024 + (ob ^ (((ob >> 9) & 1) << 5)); }
__host__ __device__ __forceinline__ void stage_rc(int b, int& R, int& C) { const int st = b / 1024, sb = b % 1024, swz = sb ^ (((sb >> 9) & 1) << 5); R = (st >> 1) * 16 + swz / 64; C = (st & 1) * 32 + (swz % 64) / 2; }
struct Unit { int pm, pn; };
struct Gemm { const bf16_t* A; const bf16_t* Bt; int M, N, K; };
struct StaticOrder {
    int nM, nN, nwg, G, c, i0, i1;
    __device__ void init(int M, int N, int G_, int c_) { nM = M / BM; nN = N / BM; nwg = nM * nN; G = G_; c = c_; i0 = 0; i1 = 1 << 30; }
    __device__ bool next(int i_, Unit& u) const {
        const int i = i_ + i0; if (i >= i1) return false;
        const long L = (long)i * G + c; if (L >= nwg) return false;
        int wgid = (int)L; { const int q = nwg / NXCD, r = nwg % NXCD, xcd = wgid % NXCD, off = wgid / NXCD; wgid = (xcd < r ? xcd * (q + 1) : r * (q + 1) + (xcd - r) * q) + off; }
        const int nig = WGM * nN, gid = wgid / nig, fm = gid * WGM, gsz = (nM - fm) < WGM ? (nM - fm) : WGM;
        u.pm = fm + ((wgid % nig) % gsz); u.pn = (wgid % nig) / gsz; return true;
    }
};
struct OneUnit { Unit u; __device__ bool next(int i, Unit& o) const { if (i != 0) return false; o = u; return true; } };

template <class Epi, class Sched>
__device__ __forceinline__ void gemm_phase(LAS unsigned char* lds, const Gemm g, const Sched& S, const Epi& E) {
    const int tid = opaque_tid(), wid = __builtin_amdgcn_readfirstlane(tid >> 6), lane = tid & 63, wr = wid >> 2, wc = wid & 3, fr = lane & 15, fq = lane >> 4;
    const int K = g.K, nt = K / BK;
    unsigned voffA[2], voffB[2];
#pragma unroll
    for (int i = 0; i < 2; ++i) { int R, C; stage_rc(tid * 16 + i * 8192, R, C); voffA[i] = (unsigned)(R * K + C) * 2u; voffB[i] = voffA[i]; }
    const size_t kstep = (size_t)(BK * 2);
    const size_t hstep = (size_t)HALF * K * 2;
    const size_t tstep = 2 * hstep;
    const unsigned ldsw = (unsigned)wid * 1024u;
    const int aoff = lds_byte(wr * 64 + fr, fq * 8), boff = lds_byte(wc * 32 + fr, fq * 8);
#define PG8_SA(b, h) (((b) * 2 + (h)) * HTB)
#define PG8_SB(b, h) ((4 + (b) * 2 + (h)) * HTB)
#define PG8_STAGE(bufoff, gbase, voff) do { _Pragma("unroll") for (int _i = 0; _i < 2; ++_i) \
        __builtin_amdgcn_global_load_lds((const unsigned*)((const char*)(gbase) + (voff)[_i]), (LAS unsigned*)(lds + (bufoff) + ldsw + _i * 8192), 16, 0, 0); } while (0)
#define PG8_LDA(dst, b, h) do { _Pragma("unroll") for (int m = 0; m < 4; ++m) _Pragma("unroll") for (int k = 0; k < 2; ++k) dst[m][k] = *(const LAS bf16x8*)(lds + PG8_SA(b, h) + aoff + m * 2048 + k * 1024); } while (0)
#define PG8_LDB(dst, b, h) do { _Pragma("unroll") for (int n = 0; n < 2; ++n) _Pragma("unroll") for (int k = 0; k < 2; ++k) dst[n][k] = *(const LAS bf16x8*)(lds + PG8_SB(b, h) + boff + n * 2048 + k * 1024); } while (0)
#define PG8_MMA(ai, bj, At, Bt) do { __builtin_amdgcn_s_setprio(1); _Pragma("unroll") for (int m = 0; m < 4; ++m) _Pragma("unroll") for (int n = 0; n < 2; ++n) _Pragma("unroll") for (int k = 0; k < 2; ++k) \
        acc[ai][bj][m][n] = __builtin_amdgcn_mfma_f32_16x16x32_f16(__builtin_bit_cast(h16x8, Bt[n][k]), __builtin_bit_cast(h16x8, At[m][k]), acc[ai][bj][m][n], 0, 0, 0); __builtin_amdgcn_s_setprio(0); } while (0)
#define PG8_WAIT_V(n) asm volatile("s_waitcnt vmcnt(" #n ")" ::: "memory")
#define PG8_WAIT_L(n) asm volatile("s_waitcnt lgkmcnt(" #n ")" ::: "memory")
#define PG8_BAR __builtin_amdgcn_s_barrier()
#define PG8_SCHED __builtin_amdgcn_sched_barrier(0)
    Unit cur, nxt; int ui = 0;
    if (!S.next(0, cur)) return;
    f32x4 acc[2][2][4][2];
#pragma unroll
    for (int a = 0; a < 2; ++a)
#pragma unroll
        for (int b = 0; b < 2; ++b)
#pragma unroll
            for (int m = 0; m < 4; ++m)
#pragma unroll
                for (int n = 0; n < 2; ++n) acc[a][b][m][n] = (f32x4){0.f, 0.f, 0.f, 0.f};
    bf16x8 At[4][2], B0[2][2], B1[2][2];
    const char* cA = (const char*)g.A + (size_t)cur.pm * tstep; const char* cB = (const char*)g.Bt + (size_t)cur.pn * tstep;
    PG8_STAGE(PG8_SB(0, 0), cB, voffB); PG8_STAGE(PG8_SA(0, 0), cA, voffA); PG8_STAGE(PG8_SB(0, 1), cB + hstep, voffB); PG8_STAGE(PG8_SA(0, 1), cA + hstep, voffA);
    if (wr == 1) PG8_BAR;
    PG8_WAIT_V(4); PG8_BAR;
    PG8_STAGE(PG8_SB(1, 0), cB + kstep, voffB); PG8_STAGE(PG8_SA(1, 0), cA + kstep, voffA); PG8_STAGE(PG8_SB(1, 1), cB + hstep + kstep, voffB);
    PG8_WAIT_V(6); PG8_BAR;
    for (;;) {
        const bool has_next = S.next(ui + 1, nxt);
        const char* nA = has_next ? (const char*)g.A + (size_t)nxt.pm * tstep : cA; const char* nB = has_next ? (const char*)g.Bt + (size_t)nxt.pn * tstep : cB;
        for (int t = 0; t < nt; t += 2) {
            const bool last = (t == nt - 2);
            const char* a1 = cA + (size_t)(t + 1) * kstep;
            const char* a2 = last ? nA : cA + (size_t)(t + 2) * kstep; const char* b2 = last ? nB : cB + (size_t)(t + 2) * kstep;
            const char* a3 = a2 + kstep; const char* b3 = b2 + kstep;
            if constexpr (Epi::HAS_MID) { if (t == Epi::MID_T) E.mid(acc, cur, wr, wc, fr, fq); }
            PG8_LDB(B0, 0, 0); PG8_SCHED; PG8_LDA(At, 0, 0); PG8_STAGE(PG8_SA(1, 1), a1 + hstep, voffA);
            PG8_WAIT_L(8); PG8_BAR; PG8_WAIT_L(0); PG8_MMA(0, 0, At, B0); PG8_BAR; PG8_SCHED;
            PG8_LDB(B1, 0, 1); PG8_STAGE(PG8_SB(0, 0), b2, voffB);
            PG8_BAR; PG8_WAIT_L(0); PG8_MMA(0, 1, At, B1); PG8_BAR;
            PG8_LDA(At, 0, 1); PG8_STAGE(PG8_SA(0, 0), a2, voffA);
            PG8_BAR; PG8_WAIT_L(0); PG8_MMA(1, 0, At, B0); PG8_BAR; PG8_SCHED;
            PG8_STAGE(PG8_SB(0, 1), b2 + hstep, voffB);
            PG8_WAIT_V(6); PG8_BAR; PG8_MMA(1, 1, At, B1); PG8_BAR;
            PG8_LDB(B0, 1, 0); PG8_SCHED; PG8_LDA(At, 1, 0); PG8_STAGE(PG8_SA(0, 1), a2 + hstep, voffA);
            PG8_WAIT_L(8); PG8_BAR; PG8_WAIT_L(0); PG8_MMA(0, 0, At, B0); PG8_BAR; PG8_SCHED;
            PG8_LDB(B1, 1, 1); PG8_STAGE(PG8_SB(1, 0), b3, voffB);
            PG8_BAR; PG8_WAIT_L(0); PG8_MMA(0, 1, At, B1); PG8_BAR;
            PG8_LDA(At, 1, 1); PG8_STAGE(PG8_SA(1, 0), a3, voffA);
            PG8_BAR; PG8_WAIT_L(0); PG8_MMA(1, 0, At, B0); PG8_BAR; PG8_SCHED;
            PG8_STAGE(PG8_SB(1, 1), b3 + hstep, voffB);
            PG8_WAIT_V(6); PG8_BAR; PG8_MMA(1, 1, At, B1); PG8_BAR;
        }
        if constexpr (!Epi::AFTER_DRAIN) { E(acc, cur, wr, wc, fr, fq); }
        if (!has_next) break;
#pragma unroll
        for (int a = 0; a < 2; ++a)
#pragma unroll
            for (int b = 0; b < 2; ++b)
#pragma unroll
                for (int m = 0; m < 4; ++m)
#pragma unroll
                    for (int n = 0; n < 2; ++n) acc[a][b][m][n] = (f32x4){0.f, 0.f, 0.f, 0.f};
        cur = nxt; cA = nA; cB = nB; ++ui;
    }
    PG8_WAIT_V(0);
    if (wr == 0) PG8_BAR;
    PG8_BAR;
    if constexpr (Epi::AFTER_DRAIN) { E.fused(acc, cur, wr, wc, fr, fq, lds, wid, lane); }
#undef PG8_SA
#undef PG8_SB
#undef PG8_STAGE
#undef PG8_LDA
#undef PG8_LDB
#undef PG8_MMA
#undef PG8_WAIT_V
#undef PG8_WAIT_L
#undef PG8_BAR
#undef PG8_SCHED
}
}
using pg8::Unit;

struct Tok { int is_p, b, t, pos; };
__device__ __forceinline__ Tok tok_of(int m) { Tok k; if (m < NPT) { k.is_p = 1; k.b = m >> 12; k.t = m & 4095; k.pos = k.t; } else { const int s = m - NPT; k.is_p = 0; k.b = s >> 3; k.t = s & 7; k.pos = 2048 + k.t; } return k; }

template <class RM, class CM>
__device__ __forceinline__ void convT(bf16_t* dst, int ldd, int koff, int K, int nN, const float* src, int srcN, RM rowmap, CM colmap, size_t gtid, size_t gsz) {
    const size_t total = (size_t)nN * (K / 8);
    for (size_t i = gtid; i < total; i += gsz) {
        const int n = (int)(i % nN), kg = (int)(i / nN); const int c = colmap(n);
        float v[8];
#pragma unroll
        for (int j = 0; j < 8; ++j) v[j] = (c >= 0) ? src[(size_t)(kg * 8 + j) * srcN + c] : 0.f;
        u32x4 w; w.x = cvt_pk_bf16(v[0], v[1]); w.y = cvt_pk_bf16(v[2], v[3]); w.z = cvt_pk_bf16(v[4], v[5]); w.w = cvt_pk_bf16(v[6], v[7]);
        *(u32x4*)(dst + (size_t)rowmap(n) * ldd + koff + kg * 8) = w;
    }
}

template <class RM, class CM>
__device__ __forceinline__ void convTs(bf16_t* dst, int ldd, int koff, int K, int nN, const float* src, int srcN, const float* kscale, RM rowmap, CM colmap, size_t gtid, size_t gsz) {
    const unsigned total = (unsigned)nN * (unsigned)(K / 8), st = (unsigned)gsz;
#pragma unroll 1
    for (unsigned i0 = (unsigned)gtid; i0 < total; i0 += 4u * st) {
        float v[4][8];
#pragma unroll
        for (int q = 0; q < 4; ++q) { const unsigned i = i0 + (unsigned)q * st; const bool ok = i < total; const unsigned ii = ok ? i : 0u; const int n = (int)(ii % (unsigned)nN), kg = (int)(ii / (unsigned)nN); const int c = colmap(n);
#pragma unroll
            for (int j = 0; j < 8; ++j) v[q][j] = (c >= 0) ? src[(size_t)(kg * 8 + j) * srcN + c] : 0.f; }
#pragma unroll
        for (int q = 0; q < 4; ++q) { const unsigned i = i0 + (unsigned)q * st; if (i < total) { const int n = (int)(i % (unsigned)nN), kg = (int)(i / (unsigned)nN);
            f32x4 s0 = (f32x4){1.f, 1.f, 1.f, 1.f}, s1 = s0; if (kscale) { s0 = *(const f32x4*)(kscale + kg * 8); s1 = *(const f32x4*)(kscale + kg * 8 + 4); }
            u32x4 w; w.x = cvt_pk_bf16(v[q][0] * s0[0], v[q][1] * s0[1]); w.y = cvt_pk_bf16(v[q][2] * s0[2], v[q][3] * s0[3]); w.z = cvt_pk_bf16(v[q][4] * s1[0], v[q][5] * s1[1]); w.w = cvt_pk_bf16(v[q][6] * s1[2], v[q][7] * s1[3]);
            *(u32x4*)(dst + (size_t)rowmap(n) * ldd + koff + kg * 8) = w; } }
    }
}

__device__ __forceinline__ void phase0(int bid, int nb) {
    CParams& p = kparams();
    const int tid = opaque_tid(), lane = tid & 63;
    const size_t gtid = (size_t)bid * NTHR + tid, gsz = (size_t)nb * NTHR;
    unsigned char* ws = p.ws;
    auto idm = [](int n) { return n; };
    convTs((bf16_t*)(ws + W_BT1), 1024, 0, 1024, 5376, p.in[9], 5176, nullptr, idm,
          [](int n) { return n < 1824 ? n : (n < 1848 ? 3104 + (n - 1824) : (n < 2048 ? -1 : (n < 3328 ? 1824 + (n - 2048) : ((((n - 3328) >> 7) & 1) ? 4152 : 3128) + ((n - 3328) >> 8) * 128 + ((n - 3328) & 127)))); }, gtid, gsz);
    for (int c = 0; c < 2; ++c)
        for (int hf = 0; hf < 2; ++hf)
            convT((bf16_t*)(ws + W_BTC1) + (size_t)(c * 256 + hf * 128) * 1024, 1024, 0, 1024, 128, p.in[22] + (size_t)(c * 2048 + hf * 1024) * 128, 128, idm, idm, gtid, gsz);
    for (int c = 0; c < 2; ++c) convT((bf16_t*)(ws + W_BTC2) + (size_t)c * 64 * 128, 128, 0, 128, 64, p.in[23] + (size_t)c * 128 * 64, 64, idm, idm, gtid, gsz);
    convT((bf16_t*)(ws + W_BTDEC), 64, 0, 64, 512, p.in[12], 512, idm, idm, gtid, gsz);
    convT((bf16_t*)(ws + W_BTAAA), 64, 0, 64, 512, p.in[14], 512, idm, idm, gtid, gsz);
    convT((bf16_t*)(ws + W_BTGATE), 160, 0, 160, 512, p.in[15], 512, idm, idm, gtid, gsz);
    for (size_t i = gtid; i < 4096 * 8; i += gsz) {
        const int pos = (int)(i >> 3), k = (int)(i & 7);
        const float inv = powf(500000.0f, -(float)k / 8.0f); const float ang = (float)pos * inv;
        float s, c; sincosf(ang, &s, &c);
        float* r = (float*)(ws + W_ROPE); r[i * 2] = c; r[i * 2 + 1] = s;
    }
    for (size_t i = gtid; i < (size_t)NTOK; i += gsz) { ((float*)(ws + W_RS1))[i] = 0.f; ((float*)(ws + W_RS2))[i] = 0.f; }
    {
        const int gw = (int)(gtid >> 6), nw = (int)(gsz >> 6);
        for (int o = gw; o < 512; o += nw) {
            const int c = o >> 8, n = o & 255, hf = n >> 7, hh = n & 127;
            const float* pe = p.in[21] + (size_t)(c * 32 + hf * 16) * 64; const float* w1 = p.in[22] + (size_t)(c * 2048 + hf * 1024) * 128 + hh;
            float s = 0.f;
            for (int k = lane; k < 1024; k += 64) s += pe[k] * w1[(size_t)k * 128];
#pragma unroll
            for (int o2 = 32; o2 > 0; o2 >>= 1) s += __shfl_xor(s, o2);
            if (lane == 0) ((float*)(ws + W_BIASC))[o] = s;
        }
    }
    {
        const int gw = (int)(gtid >> 6), nw = (int)(gsz >> 6);
        const float* gm = p.in[8];
        f32x4 g[4];
#pragma unroll
        for (int j = 0; j < 4; ++j) g[j] = *(const f32x4*)(gm + j * 256 + lane * 4);
#pragma unroll 1
        for (int m0 = gw; m0 < NTOK; m0 += 4 * nw) {
            f32x4 v[4][4];
#pragma unroll
            for (int q = 0; q < 4; ++q) { const int mm = min(m0 + q * nw, NTOK - 1); const float* x = (mm < NPT) ? p.in[0] + (size_t)mm * 1024 : p.in[1] + (size_t)(mm - NPT) * 1024;
#pragma unroll
                for (int j = 0; j < 4; ++j) v[q][j] = *(const f32x4*)(x + j * 256 + lane * 4); }
#pragma unroll
            for (int q = 0; q < 4; ++q) { const int m = m0 + q * nw; if (m < NTOK) {
                float ss = 0.f;
#pragma unroll
                for (int j = 0; j < 4; ++j) ss += v[q][j][0] * v[q][j][0] + v[q][j][1] * v[q][j][1] + v[q][j][2] * v[q][j][2] + v[q][j][3] * v[q][j][3];
#pragma unroll
                for (int o2 = 32; o2 > 0; o2 >>= 1) ss += __shfl_xor(ss, o2);
                const float rs = rsqrtf(ss * (1.0f / 1024.0f) + 1e-6f);
                bf16_t* h = (bf16_t*)(ws + W_H) + (size_t)m * 1024;
#pragma unroll
                for (int j = 0; j < 4; ++j) *(u32x2*)(h + j * 256 + lane * 4) = pack4(v[q][j] * rs * g[j]); } }
        }
    }
}

__device__ __forceinline__ f32x4 rope4(f32x4 v, int fq, int pos, const float* rope) {
    f32x4 o;
#pragma unroll
    for (int j = 0; j < 4; ++j) {
        const float other = __shfl_xor(v[j], 32); const int i = 4 * (fq & 1) + j; const f32x2 cs = *(const f32x2*)(rope + pos * 16 + i * 2);
        o[j] = (fq < 2) ? v[j] * cs.x - other * cs.y : v[j] * cs.x + other * cs.y;
    }
    return o;
}

__device__ __forceinline__ f32x4 rope4c(f32x4 v, int fq, f32x4 c0, f32x4 c1) {
    f32x4 o;
#pragma unroll
    for (int j = 0; j < 4; ++j) {
        const float other = __shfl_xor(v[j], 32); const float cx = j < 2 ? c0[2 * (j & 1)] : c1[2 * (j & 1)], sx = j < 2 ? c0[2 * (j & 1) + 1] : c1[2 * (j & 1) + 1];
        o[j] = (fq < 2) ? v[j] * cx - other * sx : v[j] * cx + other * sx;
    }
    return o;
}
struct EpiG1 {
    static constexpr bool AFTER_DRAIN = false, HAS_MID = false; static constexpr int MID_T = 0;
    float* out; unsigned char* ws;
    __device__ __forceinline__ void mid(f32x4 (&)[2][2][4][2], const Unit&, int, int, int, int) const {}
    __device__ __forceinline__ void operator()(const f32x4 (&acc)[2][2][4][2], const Unit& u, int wr, int wc, int fr, int fq) const {
        const int pn = u.pn; const float* rope = (const float*)(ws + W_ROPE);
#pragma unroll
        for (int ai = 0; ai < 2; ++ai)
#pragma unroll
            for (int m = 0; m < 4; ++m) {
                const int row = u.pm * 256 + ai * 128 + wr * 64 + m * 16 + fr; const Tok tk = tok_of(row);
                f32x4 rc0 = (f32x4){0.f, 0.f, 0.f, 0.f}, rc1 = rc0;
                if (pn >= 8 && pn < 13 && pn != 10 && (wc & 1) == 0) { const float* rp = rope + tk.pos * 16 + 8 * (fq & 1); rc0 = *(const f32x4*)rp; rc1 = *(const f32x4*)(rp + 4); }
#pragma unroll
                for (int bj = 0; bj < 2; ++bj)
#pragma unroll
                    for (int n = 0; n < 2; ++n) {
                        const int cl = bj * 128 + wc * 32 + n * 16 + fq * 4; f32x4 v = acc[ai][bj][m][n];
                        if (pn < 8) {
                            const int c = pn * 256 + cl;
                            if (c < 1824) {
                                *(u32x2*)((bf16_t*)(ws + W_P) + (size_t)row * 1824 + c) = pack4(v);
                                if (tk.is_p) { if (tk.t == 4095) *(f32x4*)(out + O_PSHIFT + (size_t)tk.b * 1824 + c) = v; }
                                else { if (tk.t == 7) *(f32x4*)(out + O_SSHIFT + (size_t)tk.b * 1824 + c) = v; }
                            } else if (c < 1848) {
                                f32x4 s; s[0] = sigmoidf_(v[0]); s[1] = sigmoidf_(v[1]); s[2] = sigmoidf_(v[2]); s[3] = sigmoidf_(v[3]);
                                *(f32x4*)((float*)(ws + W_GN) + (size_t)row * 24 + (c - 1824)) = s;
                            }
                        } else if (pn < 10) {
                            const int c = (pn - 8) * 256 + cl; v = v * 0.18033688011112042f;
                            *(u32x2*)((bf16_t*)(ws + W_QC) + (size_t)row * 512 + c) = pack4(v);
                            if ((wc & 1) == 0 && n == 0) v = rope4c(v, fq, rc0, rc1);
                            *(u32x2*)((bf16_t*)(ws + W_QR) + (size_t)row * 512 + c) = pack4(v);
                        } else if (pn < 13) {
                            const int g = wc >> 1, d = (wc & 1) * 32 + n * 16 + fq * 4;
                            if (pn > 10 && bj == 0 && (wc & 1) == 0 && n == 0) v = rope4c(v, fq, rc0, rc1);
                            if (pn == 10) {
                                *(f32x4*)(out + (tk.is_p ? O_PCMP + (size_t)row * 256 : O_SCMP + (size_t)(row - NPT) * 256) + cl) = v;
                                if (tk.is_p) *(u32x2*)((bf16_t*)(ws + W_CPM) + (size_t)bj * 2048 * 1024 + (size_t)((tk.b * 2 + g) * 256 + (tk.t >> 4)) * 1024 + (tk.t & 15) * 64 + d) = pack4(v);
                            } else {
                                if (pn == 11) *(f32x4*)(out + (tk.is_p ? O_PSLC + (size_t)row * 256 : O_SSLC + (size_t)(row - NPT) * 256) + cl) = v;
                                else {
                                    if (tk.is_p) { if (tk.t >= 3584) *(f32x4*)(out + O_PWIN + ((size_t)tk.b * 512 + (tk.t - 3584)) * 256 + cl) = v; }
                                    else *(f32x4*)(out + O_SWIN + ((size_t)tk.b * 512 + 504 + tk.t) * 256 + cl) = v;
                                }
                                if (tk.is_p) {
                                    if (bj == 0) *(u32x2*)((bf16_t*)(ws + (pn == 11 ? W_KS : W_KW)) + ((size_t)(tk.b * 2 + g) * 4096 + tk.t) * 64 + d) = pack4(v);
                                    else { bf16_t* vt = (bf16_t*)(ws + (pn == 11 ? W_VST : W_VWT)) + ((size_t)(tk.b * 2 + g) * 64 + d) * 4096 + tk.t;
#pragma unroll
                                        for (int j = 0; j < 4; ++j) vt[(size_t)j * 4096] = f2bf(v[j]); }
                                }
                            }
                        } else if (bj == 0) {
                            const f32x4 vn = acc[ai][1][m][n]; f32x4 rt, sn;
#pragma unroll
                            for (int j = 0; j < 4; ++j) { const float eb1 = 1.0f + __expf(-vn[j]);
                                sn[j] = fmaxf(__builtin_amdgcn_rcpf(eb1), 1e-6f); rt[j] = sigmoidf_(v[j]) * fminf(eb1, 1e6f); }
                            const int col = (pn - 13) * 128 + wc * 32 + n * 16 + fq * 4;
                            *(u32x2*)((bf16_t*)(ws + W_GATES) + (size_t)row * 2048 + col) = pack4(rt);
                            *(u32x2*)((bf16_t*)(ws + W_GATES) + (size_t)row * 2048 + 1024 + col) = pack4(sn);
                        }
                    }
            }
    }
};

struct EpiCmp {
    static constexpr bool AFTER_DRAIN = true, HAS_MID = false; static constexpr int MID_T = 0;
    unsigned char* ws; int gs  ; int per_c  ; bf16_t* KC; bf16_t* VCT;
    __device__ __forceinline__ void mid(f32x4 (&)[2][2][4][2], const Unit&, int, int, int, int) const {}
    __device__ __forceinline__ void operator()(const f32x4 (&)[2][2][4][2], const Unit&, int, int, int, int) const {}
    __device__ __forceinline__ void fused(f32x4 (&acc)[2][2][4][2], const Unit& u, int wr, int wc, int fr, int fq, LAS unsigned char* lds, int wid, int lane) const {
        const int c = u.pn, pmr = u.pm - c * per_c;
        LAS float* HS = (LAS float*)lds;
        LAS bf16_t* HB = (LAS bf16_t*)lds;
        const float* bias = (const float*)(ws + W_BIASC) + c * 256;
#pragma unroll
        for (int ai = 0; ai < 2; ++ai)
#pragma unroll
            for (int m = 0; m < 4; ++m) { const int rl = ai * 128 + wr * 64 + m * 16 + fr;
#pragma unroll
                for (int n = 0; n < 2; ++n) *(LAS f32x4*)(HS + rl * 132 + wc * 32 + n * 16 + fq * 4) = acc[ai][1][m][n]; }
        __syncthreads();
#pragma unroll
        for (int ai = 0; ai < 2; ++ai)
#pragma unroll
            for (int m = 0; m < 4; ++m) { const int rl = ai * 128 + wr * 64 + m * 16 + fr; const bool ok = (rl % gs) < gs - 1;
#pragma unroll
                for (int n = 0; n < 2; ++n) { const int h = wc * 32 + n * 16 + fq * 4;
                    f32x4 r = (f32x4){0.f, 0.f, 0.f, 0.f};
                    if (ok) { const f32x4 hs = *(const LAS f32x4*)(HS + (rl + 1) * 132 + h); const f32x4 b0 = *(const f32x4*)(bias + h), b1 = *(const f32x4*)(bias + 128 + h);
                        const f32x4 x = acc[ai][0][m][n] + hs + b0 + b1;
#pragma unroll
                        for (int j = 0; j < 4; ++j) r[j] = x[j] * sigmoidf_(x[j]); }
                    acc[ai][0][m][n] = r; } }
        __syncthreads();
#pragma unroll
        for (int ai = 0; ai < 2; ++ai)
#pragma unroll
            for (int m = 0; m < 4; ++m) { const int rl = ai * 128 + wr * 64 + m * 16 + fr;
#pragma unroll
                for (int n = 0; n < 2; ++n) *(LAS u32x2*)(HB + rl * 136 + wc * 32 + n * 16 + fq * 4) = pack4(acc[ai][0][m][n]); }
        __syncthreads();
        const bf16_t* w2 = (const bf16_t*)(ws + W_BTC2) + (size_t)c * 64 * 128;
        bf16x8 wfr[4][4];
#pragma unroll
        for (int ct = 0; ct < 4; ++ct)
#pragma unroll
            for (int ks = 0; ks < 4; ++ks) wfr[ct][ks] = *(const bf16x8*)(w2 + (size_t)(ct * 16 + fr) * 128 + ks * 32 + fq * 8);
#pragma unroll
        for (int rt = 0; rt < 2; ++rt) {
            bf16x8 hfr[4];
#pragma unroll
            for (int ks = 0; ks < 4; ++ks) hfr[ks] = *(const LAS bf16x8*)(HB + (wid * 32 + rt * 16 + fr) * 136 + ks * 32 + fq * 8);
#pragma unroll
            for (int ct = 0; ct < 4; ++ct) {
                f32x4 d = (f32x4){0.f, 0.f, 0.f, 0.f};
#pragma unroll
                for (int ks = 0; ks < 4; ++ks) { const bf16x8 wf = wfr[ct][ks];
                    d = (c == 0) ? mfma16(wf, hfr[ks], d) : mfma16(hfr[ks], wf, d); }
                if (c == 0) {
                    const size_t Rg = (size_t)pmr * 256 + wid * 32 + rt * 16 + fr;
                    *(u32x2*)(KC + Rg * 64 + ct * 16 + fq * 4) = pack4(d);
                } else {
                    const size_t Rg = (size_t)pmr * 256 + wid * 32 + rt * 16 + fq * 4; const size_t pair = Rg / gs, nn = Rg % gs;
                    *(u32x2*)(VCT + (pair * 64 + ct * 16 + fr) * gs + nn) = pack4(d);
                }
            }
        }
        __syncthreads();
    }
};

constexpr unsigned SWIN_TOTAL = 128u * 504u * 64u, SWIN_SPLIT = (SWIN_TOTAL / 4u) * 3u;
__device__ __forceinline__ void swin_copy(CParams& p, int part, int nparts, unsigned lo, unsigned total) {
    const f32x4* src = (const f32x4*)p.in[4]; f32x4* dst = (f32x4*)(p.out + O_SWIN);
    const unsigned stride = (unsigned)nparts * NTHR;
    unsigned i = lo + (unsigned)part * NTHR + (unsigned)opaque_tid();
    for (; i + 3u * stride < total; i += 4u * stride) {
        unsigned o[4]; f32x4 v[4];
#pragma unroll
        for (int j = 0; j < 4; ++j) { const unsigned ii = i + (unsigned)j * stride, b = ii / (504u * 64u), r = ii - b * (504u * 64u); o[j] = b * (512u * 64u) + r; v[j] = src[o[j] + 8u * 64u]; }
#pragma unroll
        for (int j = 0; j < 4; ++j) dst[o[j]] = v[j];
    }
    for (; i < total; i += stride) { const unsigned b = i / (504u * 64u), r = i - b * (504u * 64u); dst[b * (512u * 64u) + r] = src[b * (512u * 64u) + 8u * 64u + r]; }
}
__device__ __forceinline__ void csm_gather(CParams& p, int uidx) {
    const int tid = opaque_tid(), d8 = tid & 7, g = (tid >> 3) & 1, r0 = tid >> 4;
    const int c = uidx >> 7, seq = uidx & 127;
    const int* pt = (const int*)p.in[7] + seq * 16;
    const float* cc = p.in[2] + c * 128 + g * 64 + d8 * 8;
    bf16_t* dst = (bf16_t*)(p.ws + W_CSM) + ((size_t)c * 32768 + (size_t)(seq * 2 + g) * 128) * 1024 + d8 * 8;
#pragma unroll 1
    for (int it = 0; it < 4; ++it) {
        f32x4 a[16], b[16];
#pragma unroll
        for (int j = 0; j < 16; ++j) { const int rowi = it * 512 + j * 32 + r0; const int page = pt[it * 4 + (j >> 2)];
            const float* src = cc + ((size_t)page * 128 + (rowi & 127)) * 256; a[j] = *(const f32x4*)src; b[j] = *(const f32x4*)(src + 4); }
#pragma unroll
        for (int j = 0; j < 16; ++j) { const int rowi = it * 512 + j * 32 + r0;
            u32x4 w; w.x = cvt_pk_bf16(a[j][0], a[j][1]); w.y = cvt_pk_bf16(a[j][2], a[j][3]); w.z = cvt_pk_bf16(b[j][0], b[j][1]); w.w = cvt_pk_bf16(b[j][2], b[j][3]);
            *(u32x4*)(dst + (size_t)(rowi >> 4) * 1024 + (rowi & 15) * 64) = w; }
    }
    asm volatile("s_waitcnt vmcnt(0)" ::: "memory");
    __syncthreads();
}
__device__ __forceinline__ void phase1(LAS unsigned char* lds, int bid, int nb) {
    CParams& p = kparams();
    const int ksplit = bid % 7;
#pragma unroll 1
    for (int s = 0; s < 3; ++s) {
        if (s == 1) {
            pg8::Gemm g{(const bf16_t*)(p.ws + W_CSM), (const bf16_t*)(p.ws + W_BTC1), 65536, 512, 1024};
            EpiCmp E{p.ws, 128, 128, (bf16_t*)(p.ws + W_KCS), (bf16_t*)(p.ws + W_VCST)};
            for (int uidx = bid; uidx < 256; uidx += nb) { csm_gather(p, uidx); pg8::OneUnit S{{uidx, uidx >> 7}}; pg8::gemm_phase(lds, g, S, E); }
        } else {
            pg8::Gemm g{(const bf16_t*)(p.ws + W_H), (const bf16_t*)(p.ws + W_BT1), NTOK, 5376, 1024};
            pg8::StaticOrder S; S.init(NTOK, 5376, nb, bid); if (s == 0) S.i1 = ksplit; else S.i0 = ksplit;
            EpiG1 E{p.out, p.ws};
            pg8::gemm_phase(lds, g, S, E);
        }
    }
    {
        const int first = ((NTOK / 256) * 21) % nb;
        if (bid >= first) swin_copy(p, bid - first, nb - first, 0u, SWIN_SPLIT);
    }
}

struct PrepRow { const unsigned char* pb; unsigned po; bool hasprev; const float* shift0; const float* mu; };
__device__ __forceinline__ f32x8 prep_xs8(const PrepRow& R, int c0) {
    const f32x8 pc = ld_bf8((const bf16_t*)(R.pb + (R.po + (unsigned)c0 * 2u))); f32x8 pp;
    if (R.hasprev) pp = ld_bf8((const bf16_t*)(R.pb + (R.po - 3648u + (unsigned)c0 * 2u)));
    else if (R.shift0) { const f32x4 a = *(const f32x4*)(R.shift0 + c0), b = *(const f32x4*)(R.shift0 + c0 + 4); pp = (f32x8){a[0], a[1], a[2], a[3], b[0], b[1], b[2], b[3]}; }
    else pp = (f32x8){0.f, 0.f, 0.f, 0.f, 0.f, 0.f, 0.f, 0.f};
    const f32x4 m0 = *(const f32x4*)(R.mu + c0), m1 = *(const f32x4*)(R.mu + c0 + 4);
    const f32x8 m = (f32x8){m0[0], m0[1], m0[2], m0[3], m1[0], m1[1], m1[2], m1[3]};
    return pc + (pp - pc) * m;
}
__device__ __forceinline__ f32x4 prep_xs4(const PrepRow& R, int c0) {
    const f32x4 pc = ld_bf4((const bf16_t*)(R.pb + (R.po + (unsigned)c0 * 2u))); f32x4 pp;
    if (R.hasprev) pp = ld_bf4((const bf16_t*)(R.pb + (R.po - 3648u + (unsigned)c0 * 2u)));
    else if (R.shift0) pp = *(const f32x4*)(R.shift0 + c0);
    else pp = (f32x4){0.f, 0.f, 0.f, 0.f};
    const f32x4 m = *(const f32x4*)(R.mu + c0);
    return pc + (pp - pc) * m;
}

#define PREP_ST(arr, nc, val) (*(u32x2*)(ws + (arr) + (om + (unsigned)(nc) * 2u)) = pack4(val))
struct PrepTile { bf16x8 wd[2], wa[2], wg[5]; f32x4 xr, xk, xv, w0, a0, k_k, k_a, rkv; };
__device__ __forceinline__ void prep_ld(PrepTile& t, CParams& p, const PrepRow& R, const bf16_t* Wd, const bf16_t* Wa, const bf16_t* Wg, int n0, int fr, int fq) {
    const int nc = n0 + 4 * fq;
#pragma unroll
    for (int ks = 0; ks < 2; ++ks) { t.wd[ks] = *(const bf16x8*)(Wd + (size_t)(n0 + fr) * 64 + ks * 32 + fq * 8); t.wa[ks] = *(const bf16x8*)(Wa + (size_t)(n0 + fr) * 64 + ks * 32 + fq * 8); }
#pragma unroll
    for (int ks = 0; ks < 5; ++ks) t.wg[ks] = *(const bf16x8*)(Wg + (size_t)(n0 + fr) * 160 + ks * 32 + fq * 8);
    t.xr = prep_xs4(R, nc); t.xk = prep_xs4(R, 576 + nc); t.xv = prep_xs4(R, 1088 + nc);
    t.w0 = *(const f32x4*)(p.in[11] + nc); t.a0 = *(const f32x4*)(p.in[13] + nc); t.k_k = *(const f32x4*)(p.in[16] + nc); t.k_a = *(const f32x4*)(p.in[17] + nc); t.rkv = *(const f32x4*)(p.in[18] + nc);
}
__device__ __forceinline__ float prep_tile(const PrepTile& t, const bf16x8 (&Adec)[2], const bf16x8 (&Aaaa)[2], const bf16x8 (&Agate)[5], LAS unsigned char* lw, int lcol, float inv) {
    f32x4 aw = (f32x4){0.f, 0.f, 0.f, 0.f}, a_a = aw, ag = aw;
#pragma unroll
    for (int ks = 0; ks < 2; ++ks) { aw = mfma16(t.wd[ks], Adec[ks], aw); a_a = mfma16(t.wa[ks], Aaaa[ks], a_a); }
#pragma unroll
    for (int ks = 0; ks < 5; ++ks) ag = mfma16(t.wg[ks], Agate[ks], ag);
    f32x4 dec, av;
#pragma unroll
    for (int j = 0; j < 4; ++j) {
        const float z = -(t.w0[j] + aw[j]);
        const float sp = fmaxf(z, 0.f) + __logf(1.0f + __expf(-fabsf(z)));
        dec[j] = -__expf(-sp - 0.5f);
        av[j] = sigmoidf_(t.a0[j] + a_a[j]);
    }
    const f32x4 kkn = t.xk * t.k_k * inv;
    const f32x4 khv = t.xk * (1.0f + (av - 1.0f) * t.k_a);
    const f32x4 bt = t.xr * khv * t.rkv;
#define PREP_LST(ai, val) (*(LAS u32x2*)(lw + (ai) * 2304 + lcol * 2) = pack4(val))
    PREP_LST(0, t.xr); PREP_LST(1, dec); PREP_LST(2, khv); PREP_LST(3, t.xv); PREP_LST(4, -kkn); PREP_LST(5, kkn * av); PREP_LST(6, ag);
#undef PREP_LST
    return (bt[0] + bt[1]) + (bt[2] + bt[3]);
}
__device__ __forceinline__ void chunk_ops_wave(unsigned char* ws, LAS unsigned char* ldsw, int gc, int lane) {
    unsigned char* ob = ws + W_COP + (size_t)gc * 18432;
    LAS bf16_t* IMG = (LAS bf16_t*)ldsw;
    LAS float* M01 = (LAS float*)(ldsw + 1 * 2304); LAS float* M23 = (LAS float*)(ldsw + 3 * 2304); LAS float* MTT = (LAS float*)(ldsw + 6 * 2304);
    {
        const int j = lane;
        float Lc[17]; Lc[0] = 0.f;
#pragma unroll
        for (int t = 0; t < 16; ++t) Lc[t + 1] = Lc[t] + bf2f(IMG[1 * 1152 + t * 72 + j]);
        const float Lm = Lc[8], LC = Lc[16], em = __expf(-Lm);
        unsigned btp[8], ktp[8], vtp[8];
#pragma unroll
        for (int t2 = 0; t2 < 8; ++t2) {
            float bts[2], kts[2], vts[2];
#pragma unroll
            for (int e = 0; e < 2; ++e) { const int t = 2 * t2 + e;
                const float rr = bf2f(IMG[0 * 1152 + t * 72 + j]), kk = bf2f(IMG[2 * 1152 + t * 72 + j]), vv = bf2f(IMG[3 * 1152 + t * 72 + j]), aa = bf2f(IMG[4 * 1152 + t * 72 + j]), bb = bf2f(IMG[5 * 1152 + t * 72 + j]);
                const float Lt = Lc[t + 1], Lp = Lc[t];
                const float ah = aa * __expf(Lp), rh = rr * __expf(Lt), en = __expf(Lm - Lt), es = __expf(LC - Lt);
                IMG[4 * 1152 + t * 72 + j] = f2bf(ah * em); IMG[0 * 1152 + t * 72 + j] = f2bf(rh * em); IMG[5 * 1152 + t * 72 + j] = f2bf(bb * en); IMG[2 * 1152 + t * 72 + j] = f2bf(kk * en);
                ((bf16_t*)(ob + 0))[t * 72 + j] = f2bf(ah); ((bf16_t*)(ob + 0))[(16 + t) * 72 + j] = f2bf(rh);
                bts[e] = bb * es; kts[e] = kk * es; vts[e] = vv; }
            btp[t2] = cvt_pk_bf16(bts[0], bts[1]); ktp[t2] = cvt_pk_bf16(kts[0], kts[1]); vtp[t2] = cvt_pk_bf16(vts[0], vts[1]);
        }
        *(u32x4*)(ob + 8704 + j * 48) = (u32x4){btp[0], btp[1], btp[2], btp[3]}; *(u32x4*)(ob + 8704 + j * 48 + 16) = (u32x4){btp[4], btp[5], btp[6], btp[7]};
        *(u32x4*)(ob + 11776 + j * 48) = (u32x4){ktp[0], ktp[1], ktp[2], ktp[3]}; *(u32x4*)(ob + 11776 + j * 48 + 16) = (u32x4){ktp[4], ktp[5], ktp[6], ktp[7]};
        *(u32x4*)(ob + 14848 + j * 48) = (u32x4){vtp[0], vtp[1], vtp[2], vtp[3]}; *(u32x4*)(ob + 14848 + j * 48 + 16) = (u32x4){vtp[4], vtp[5], vtp[6], vtp[7]};
        ((float*)(ob + 17920))[j] = __expf(LC);
    }
    asm volatile("s_waitcnt lgkmcnt(0)" ::: "memory");
    {
        const int r = lane & 31, h = lane >> 5;
        LAS const bf16_t* hb = IMG + ((r < 16) ? 5 : 2) * 1152 + (r & 15) * 72 + h * 8; LAS const bf16_t* ha = IMG + ((r < 16) ? 4 : 0) * 1152 + (r & 15) * 72 + h * 8;
        f32x16 D;
#pragma unroll
        for (int i2 = 0; i2 < 16; ++i2) D[i2] = 0.f;
        bf16x8 fa[4], fb[4];
#pragma unroll
        for (int ks = 0; ks < 4; ++ks) { fa[ks] = *(const LAS bf16x8*)(hb + ks * 16); fb[ks] = *(const LAS bf16x8*)(ha + ks * 16); }
#pragma unroll
        for (int ks = 0; ks < 4; ++ks) D = mfma32(fa[ks], fb[ks], D);
        asm volatile("s_waitcnt lgkmcnt(0)" ::: "memory");
        const int y = r;
#pragma unroll
        for (int reg = 0; reg < 16; ++reg) { const int x = (reg & 3) + 8 * (reg >> 2) + 4 * h;
            const int xx = x & 15, yy = y & 15; const bool nz = (y < 16) ? (xx < yy) : (xx <= yy);
            LAS float* dst = (y < 16) ? M01 : M23;
            dst[(x >> 4) * 256 + xx * 16 + yy] = nz ? D[reg] : 0.f; }
    }
    asm volatile("s_waitcnt lgkmcnt(0)" ::: "memory");
    if (lane < 16) {
        const int tau = lane; float T[16];
#pragma unroll
        for (int s = 0; s < 16; ++s) { float v = (s == tau) ? 1.f : 0.f;
#pragma unroll
            for (int sg = 0; sg < s; ++sg) v += (sg >= tau) ? T[sg] * M01[sg * 16 + s] : 0.f;
            T[s] = v; }
#pragma unroll
        for (int s = 0; s < 16; ++s) MTT[tau * 16 + s] = T[s];
    }
    asm volatile("s_waitcnt lgkmcnt(0)" ::: "memory");
    {
#pragma unroll 4
        for (int k = 0; k < 16; ++k) { const int e = lane + 64 * k; const int row = e >> 5, col = e & 31; float v;
            if (row < 16) v = (col < 16) ? MTT[col * 16 + row] : 0.f;
            else { const int t = row - 16;
                if (col < 16) { v = 0.f;
#pragma unroll
                    for (int s = 0; s < 16; ++s) v += M23[s * 16 + t] * MTT[col * 16 + s]; }
                else v = (col - 16 == t) ? 1.f : 0.f; }
            ((bf16_t*)(ob + 6144))[row * 40 + col] = f2bf(v); }
#pragma unroll
        for (int k = 0; k < 8; ++k) { const int e = lane + 64 * k; const int row = e >> 4, col = e & 15;
            const float v = (row < 16) ? M01[256 + col * 16 + row] : M23[256 + col * 16 + (row - 16)];
            ((bf16_t*)(ob + 4608))[row * 24 + col] = f2bf(v); }
    }
    asm volatile("s_waitcnt lgkmcnt(0)" ::: "memory");
}

__device__ __forceinline__ void prep_item(CParams& p, LAS unsigned char* ldsw, int grp, int hp, int lane_in, int hh0, int hh1) {
    unsigned char* ws = p.ws;
    int lane = lane_in; asm volatile("" : "+v"(lane));
    const int fr = lane & 15, fq = lane >> 4;
    const int m = grp * 16 + fr; const Tok tk = tok_of(m);
    PrepRow R; R.pb = ws + W_P; R.po = (unsigned)m * 3648u; R.hasprev = tk.t > 0;
    R.shift0 = (!tk.is_p && tk.t == 0) ? p.in[6] + (size_t)tk.b * 1824 : nullptr; R.mu = p.in[10];
    bf16x8 Adec[2], Aaaa[2], Agate[5];
    {
        f32x8 xd[2], xa[2];
#pragma unroll
        for (int ks = 0; ks < 2; ++ks) { xd[ks] = prep_xs8(R, 512 + ks * 32 + fq * 8); xa[ks] = prep_xs8(R, 1600 + ks * 32 + fq * 8); }
#pragma unroll
        for (int ks = 0; ks < 2; ++ks) {
            const f32x8 x = xd[ks], y = xa[ks];
            Adec[ks] = pack8(tanhf_(x[0]), tanhf_(x[1]), tanhf_(x[2]), tanhf_(x[3]), tanhf_(x[4]), tanhf_(x[5]), tanhf_(x[6]), tanhf_(x[7]));
            Aaaa[ks] = pack8(y[0], y[1], y[2], y[3], y[4], y[5], y[6], y[7]);
        }
        __builtin_amdgcn_sched_barrier(0);
#pragma unroll
        for (int ks = 0; ks < 5; ++ks) { const f32x8 x = prep_xs8(R, 1664 + ks * 32 + fq * 8);
            Agate[ks] = pack8(sigmoidf_(x[0]), sigmoidf_(x[1]), sigmoidf_(x[2]), sigmoidf_(x[3]), sigmoidf_(x[4]), sigmoidf_(x[5]), sigmoidf_(x[6]), sigmoidf_(x[7])); }
        __builtin_amdgcn_sched_barrier(0);
    }
    const bf16_t* Wd = (const bf16_t*)(ws + W_BTDEC); const bf16_t* Wa = (const bf16_t*)(ws + W_BTAAA); const bf16_t* Wg = (const bf16_t*)(ws + W_BTGATE);
    const unsigned om = (unsigned)m * 1024u;
#pragma unroll 1
    for (int hh = hh0; hh < hh1; ++hh) {
        const int h = hp * 2 + hh;
        float ss = 0.f;
#pragma unroll
        for (int nt = 0; nt < 4; ++nt) { const int nc = h * 64 + nt * 16 + 4 * fq; const f32x4 kr = prep_xs4(R, 576 + nc) * *(const f32x4*)(p.in[16] + nc); ss += (kr[0] * kr[0] + kr[1] * kr[1]) + (kr[2] * kr[2] + kr[3] * kr[3]); }
        ss += __shfl_xor(ss, 16); ss += __shfl_xor(ss, 32);
        const float inv = rsqrtf(fmaxf(ss, 1e-24f));
        float bsum = 0.f;
#pragma unroll 1
        for (int nt = 0; nt < 4; ++nt) {
            PrepTile tA;
            prep_ld(tA, p, R, Wd, Wa, Wg, h * 64 + nt * 16, fr, fq);
            bsum += prep_tile(tA, Adec, Aaaa, Agate, ldsw + fr * 144, nt * 16 + 4 * fq, inv);
        }
        __builtin_amdgcn_sched_barrier(0);
        const bool prompt = grp < (NPT / 16);
#pragma unroll 1
        for (int ai = 0; ai < 7; ++ai) {
            if (prompt && ai != 3 && ai != 6) continue;
#pragma unroll
            for (int ps = 0; ps < 2; ++ps) { const int tk2 = ps * 8 + (lane >> 3), c8 = lane & 7;
                const u32x4 v = *(LAS const u32x4*)(ldsw + ai * 2304 + tk2 * 144 + c8 * 16);
                *(u32x4*)(ws + W_R + (size_t)ai * RW_SZ + ((size_t)(grp * 16 + tk2) * 512 + h * 64 + c8 * 8) * 2) = v; }
        }
        if (prompt) { asm volatile("s_waitcnt lgkmcnt(0)" ::: "memory"); chunk_ops_wave(ws, ldsw, ((grp >> 8) * 8 + h) * 256 + (grp & 255), lane); }
        bsum += __shfl_xor(bsum, 16); bsum += __shfl_xor(bsum, 32);
        if (fq == 0) ((float*)(ws + W_BON))[(size_t)m * 8 + h] = bsum;
    }
}

__device__ __forceinline__ void phase2(LAS unsigned char* lds, int bid, int nb) {
    CParams& p = kparams();
    {
        pg8::Gemm g{(const bf16_t*)(p.ws + W_CPM), (const bf16_t*)(p.ws + W_BTC1), 4096, 512, 1024};
        EpiCmp E{p.ws, 256, 8, (bf16_t*)(p.ws + W_KCP), (bf16_t*)(p.ws + W_VCPT)};
        for (int uidx = bid; uidx < 16; uidx += nb) { pg8::OneUnit S{{uidx, uidx >> 3}}; pg8::gemm_phase(lds, g, S, E); }
    }
    const int tid2 = opaque_tid(); const int wv = tid2 >> 6, lane = tid2 & 63;
    const int skip = nb > 32 ? 16 : 0;
    if (bid < skip || skip == 0) swin_copy(p, bid, skip ? skip : nb, SWIN_SPLIT, SWIN_TOTAL);
    const int nitems = (NTOK / 16) * 4, nwaves = (nb - skip) * 8, nfull = (nitems / nwaves) * nwaves, nhalf = (nitems - nfull) * 2;
    if (bid >= skip) { const int w0 = (bid - skip) * 8 + wv;
#pragma unroll 1
        for (int k = w0; k < nfull + nhalf; k += nwaves) { const bool full = k < nfull; const int j = k - nfull, it = full ? k : nfull + (j >> 1), hh0 = full ? 0 : (j & 1);
            prep_item(p, lds + wv * 16128, it >> 2, it & 3, lane, hh0, full ? 2 : hh0 + 1); } }
    const int light0 = skip + ((nhalf < nwaves ? nhalf : 0) + 7) / 8;
    if (bid >= light0) {
        unsigned char* ws = p.ws;
        const size_t gtid = (size_t)(bid - light0) * NTHR + opaque_tid(), gsz = (size_t)(nb - light0) * NTHR;
        auto idm = [](int n) { return n; };
        convTs((bf16_t*)(ws + W_BTM), 1024, 0, 512, 1024, p.in[24], 1024, nullptr, idm, idm, gtid, gsz);
        convTs((bf16_t*)(ws + W_BTM), 1024, 512, 512, 1024, p.in[25], 1024, nullptr, idm, idm, gtid, gsz);
        convTs((bf16_t*)(ws + W_BTO), 1024, 0, 1024, 1024, p.in[26], 1024, nullptr, idm, idm, gtid, gsz);
        convTs((bf16_t*)(ws + W_BTGU), 1024, 0, 1024, 2816, p.in[28], 2816, p.in[27], [](int n) { return 256 * (n >> 7) + (n & 127); }, idm, gtid, gsz);
        convTs((bf16_t*)(ws + W_BTGU), 1024, 0, 1024, 2816, p.in[29], 2816, p.in[27], [](int n) { return 256 * (n >> 7) + 128 + (n & 127); }, idm, gtid, gsz);
        convTs((bf16_t*)(ws + W_BTD), 2816, 0, 2816, 1024, p.in[30], 1024, nullptr, idm, idm, gtid, gsz);
    }
}

__device__ __forceinline__ float allreduce16(float x) {
    x += dppf(x, 0); x += dppf(x, 1); x += dppf(x, 2);
    x += __int_as_float(__builtin_amdgcn_update_dpp(0, __float_as_int(x), 0x140, 0xF, 0xF, false));
    return x;
}
__device__ __forceinline__ void scan_unit(CParams& p, LAS unsigned char* lds, int unit) {
    unsigned char* ws = p.ws;
    const int tid = opaque_tid(), il = tid >> 4, q = tid & 15;
    int T, m0, h, half; const float* S0 = nullptr; float* Sout;
    if (unit < 64) { const int bh = unit >> 1; half = unit & 1; const int b = bh >> 3; h = bh & 7; T = 4096; m0 = b * 4096; Sout = p.out + O_PRWKV + (size_t)bh * 4096; }
    else { const int su = unit - 64; const int bh = su >> 1; half = su & 1; const int seq = bh >> 3; h = bh & 7; T = 8; m0 = NPT + seq * 8; S0 = p.in[5] + (size_t)bh * 4096; Sout = p.out + O_SRWKV + (size_t)bh * 4096; }
    const int i = half * 32 + il;
    LAS float* buf = (LAS float*)lds;
    f32x4 S = (f32x4){0.f, 0.f, 0.f, 0.f};
    if (S0) S = *(const f32x4*)(S0 + i * 64 + q * 4);
    const int nch = (T + 15) >> 4;
    f32x4 stg[3];
    auto gload = [&](int c) {
#pragma unroll
        for (int k = 0; k < 3; ++k) { const int idx = tid + 512 * k; const int ar = idx >> 8, st = (idx >> 4) & 15, f4 = idx & 15; const int t = c * 16 + st;
            f32x4 vv = (f32x4){0.f, 0.f, 0.f, 0.f};
            if (t < T) { vv = ld_bf4((const bf16_t*)(ws + W_R + (size_t)ar * RW_SZ) + (size_t)(m0 + t) * 512 + h * 64 + f4 * 4);
                if (ar == 1) { vv[0] = __expf(vv[0]); vv[1] = __expf(vv[1]); vv[2] = __expf(vv[2]); vv[3] = __expf(vv[3]); } }
            stg[k] = vv; }
    };
    auto lstore = [&](int bi) {
#pragma unroll
        for (int k = 0; k < 3; ++k) { const int idx = tid + 512 * k; const int ar = idx >> 8, st = (idx >> 4) & 15, f4 = idx & 15;
            *(LAS f32x4*)(buf + ((bi * 6 + ar) * 16 + st) * 64 + f4 * 4) = stg[k]; }
    };
    __syncthreads();
    gload(0); lstore(0);
    __syncthreads();
    float* yout = (float*)(ws + W_YRAW) + (size_t)m0 * 512 + h * 64 + i;
    for (int c = 0; c < nch; ++c) {
        const int bi = c & 1; const int ns = (T - c * 16) < 16 ? (T - c * 16) : 16;
        if (c + 1 < nch) gload(c + 1);
        LAS const float* bb = buf + bi * 6 * 16 * 64;
        for (int s = 0; s < ns; ++s) {
            const f32x4 rv = *(LAS const f32x4*)(bb + (0 * 16 + s) * 64 + q * 4);
            const f32x4 dv = *(LAS const f32x4*)(bb + (1 * 16 + s) * 64 + q * 4);
            const f32x4 kv = *(LAS const f32x4*)(bb + (2 * 16 + s) * 64 + q * 4);
            const float vi = bb[(3 * 16 + s) * 64 + i];
            const f32x4 av = *(LAS const f32x4*)(bb + (4 * 16 + s) * 64 + q * 4);
            const f32x4 bv = *(LAS const f32x4*)(bb + (5 * 16 + s) * 64 + q * 4);
            const f32x4 sa4 = S * av;
            const float sa = allreduce16((sa4[0] + sa4[1]) + (sa4[2] + sa4[3]));
            S = S * dv + bv * sa + kv * vi;
            const f32x4 y4 = S * rv;
            const float y = allreduce16((y4[0] + y4[1]) + (y4[2] + y4[3]));
            if (q == 0) yout[(size_t)(c * 16 + s) * 512] = y;
        }
        __syncthreads();
        if (c + 1 < nch) lstore(bi ^ 1);
        __syncthreads();
    }
    *(f32x4*)(Sout + i * 64 + q * 4) = S;
}

struct ScanOps { f32x4 rv, dv, kv, av, bv; float vi; };
__device__ __forceinline__ void scan_ldops(ScanOps& o, LAS const float* bb, int s, int q, int i) {
    o.rv = *(LAS const f32x4*)(bb + (0 * 16 + s) * 64 + q * 4); o.dv = *(LAS const f32x4*)(bb + (1 * 16 + s) * 64 + q * 4);
    o.kv = *(LAS const f32x4*)(bb + (2 * 16 + s) * 64 + q * 4); o.vi = bb[(3 * 16 + s) * 64 + i];
    o.av = *(LAS const f32x4*)(bb + (4 * 16 + s) * 64 + q * 4); o.bv = *(LAS const f32x4*)(bb + (5 * 16 + s) * 64 + q * 4);
}
__device__ __forceinline__ void scan_step(f32x4& S, const ScanOps& o, LAS float* yb) {
    const f32x4 sa4 = S * o.av;
    const f32x4 tt = S * o.dv + o.kv * o.vi;
    const float sa = allreduce16((sa4[0] + sa4[1]) + (sa4[2] + sa4[3]));
    S = o.bv * sa + tt;
    const f32x4 y4 = S * o.rv;
    *yb = (y4[0] + y4[1]) + (y4[2] + y4[3]);
}
__device__ __forceinline__ void scan_unit16(CParams& p, LAS unsigned char* lds, int unit) {
    unsigned char* ws = p.ws;
    const int tid = opaque_tid();
    const int bh = unit >> 2, quarter = unit & 3, b = bh >> 3, h = bh & 7;
    const int m0 = b * 4096;
    const bool comp = tid < 256;
    const int il = (tid >> 4) & 15, q = tid & 15, i = quarter * 16 + il, lt = tid & 255;
    LAS float* buf = (LAS float*)lds; LAS float* ybuf = buf + 2 * 6 * 16 * 64;
    f32x4 S = (f32x4){0.f, 0.f, 0.f, 0.f};
    const bf16_t* gbase = (const bf16_t*)(ws + W_R) + (size_t)m0 * 512 + h * 64 + (size_t)((lt >> 4) & 15) * 512 + (lt & 15) * 4;
    LAS float* lbase = buf + ((lt >> 4) & 15) * 64 + (lt & 15) * 4;
    float* ybase = (float*)(ws + W_YRAW) + (size_t)m0 * 512 + h * 64 + quarter * 16 + (size_t)(lt >> 4) * 512 + (lt & 15);
    auto stage = [&](int c) {
        u32x2 t[6];
#pragma unroll
        for (int k = 0; k < 6; ++k) t[k] = *(const u32x2*)(gbase + (size_t)k * (RW_SZ / 2) + (size_t)c * 16 * 512);
#pragma unroll
        for (int k = 0; k < 6; ++k) { f32x4 v; v[0] = bf_lo(t[k].x); v[1] = bf_hi(t[k].x); v[2] = bf_lo(t[k].y); v[3] = bf_hi(t[k].y);
            if (k == 1) { v[0] = __expf(v[0]); v[1] = __expf(v[1]); v[2] = __expf(v[2]); v[3] = __expf(v[3]); }
            *(LAS f32x4*)(lbase + ((c & 1) * 6 + k) * 16 * 64) = v; }
    };
    auto yflush = [&](int c) {
        LAS const float* yb = ybuf + (c & 1) * 4096 + lt * 16;
        const f32x4 a = *(LAS const f32x4*)yb, b2 = *(LAS const f32x4*)(yb + 4), c2 = *(LAS const f32x4*)(yb + 8), d = *(LAS const f32x4*)(yb + 12);
        const f32x4 s4 = (a + b2) + (c2 + d);
        ybase[(size_t)c * 16 * 512] = (s4[0] + s4[1]) + (s4[2] + s4[3]);
    };
    __syncthreads();
    if (!comp) stage(0);
    __syncthreads();
    constexpr int nch = 4096 / 16;
    for (int c = 0; c < nch; ++c) {
        if (!comp) {
            if (c + 1 < nch) stage(c + 1);
            if (c > 0) yflush(c - 1);
        } else {
            LAS const float* bb = buf + (c & 1) * 6 * 16 * 64;
            LAS float* yb = ybuf + (c & 1) * 4096 + lt;
            ScanOps oA, oB;
            scan_ldops(oA, bb, 0, q, i);
#pragma unroll
            for (int s = 0; s < 16; s += 2) {
                scan_ldops(oB, bb, s + 1, q, i);
                scan_step(S, oA, yb + s * 256);
                if (s + 2 < 16) scan_ldops(oA, bb, s + 2, q, i);
                scan_step(S, oB, yb + (s + 1) * 256);
            }
        }
        __syncthreads();
    }
    if (!comp) yflush(nch - 1);
    if (comp) *(f32x4*)(p.out + O_PRWKV + (size_t)bh * 4096 + i * 64 + q * 4) = S;
}

__device__ __forceinline__ void scan_sample4(CParams& p, LAS unsigned char* lds, int item) {
    unsigned char* ws = p.ws;
    const int tid = opaque_tid(), il = tid >> 4, q = tid & 15;
    LAS float* buf = (LAS float*)lds;
    const int bh0 = item * 2;
    f32x4 S[4];
#pragma unroll
    for (int u = 0; u < 4; ++u) S[u] = *(const f32x4*)(p.in[5] + (size_t)(bh0 + (u >> 1)) * 4096 + ((u & 1) * 32 + il) * 64 + q * 4);
    __syncthreads();
#pragma unroll
    for (int k = 0; k < 3; ++k) {
        const int idx = tid + 512 * k; const int stt = idx / 768, rem = idx - stt * 768, ar = rem >> 7, st = (rem >> 4) & 7, f4 = rem & 15;
        const int bh = bh0 + stt, seq = bh >> 3, h = bh & 7;
        f32x4 vv = ld_bf4((const bf16_t*)(ws + W_R + (size_t)ar * RW_SZ) + (size_t)(NPT + seq * 8 + st) * 512 + h * 64 + f4 * 4);
        if (ar == 1) { vv[0] = __expf(vv[0]); vv[1] = __expf(vv[1]); vv[2] = __expf(vv[2]); vv[3] = __expf(vv[3]); }
        *(LAS f32x4*)(buf + ((stt * 6 + ar) * 8 + st) * 64 + f4 * 4) = vv;
    }
    __syncthreads();
#pragma unroll
    for (int s = 0; s < 8; ++s) {
#pragma unroll
        for (int u = 0; u < 4; ++u) {
            LAS const float* bb = buf + (u >> 1) * 6 * 8 * 64; const int i = (u & 1) * 32 + il;
            const f32x4 rv = *(LAS const f32x4*)(bb + (0 * 8 + s) * 64 + q * 4), dv = *(LAS const f32x4*)(bb + (1 * 8 + s) * 64 + q * 4), kv = *(LAS const f32x4*)(bb + (2 * 8 + s) * 64 + q * 4);
            const float vi = bb[(3 * 8 + s) * 64 + i];
            const f32x4 av = *(LAS const f32x4*)(bb + (4 * 8 + s) * 64 + q * 4), bv = *(LAS const f32x4*)(bb + (5 * 8 + s) * 64 + q * 4);
            const f32x4 sa4 = S[u] * av; const f32x4 tt = S[u] * dv + kv * vi;
            const float sa = allreduce16((sa4[0] + sa4[1]) + (sa4[2] + sa4[3]));
            S[u] = bv * sa + tt;
            const f32x4 y4 = S[u] * rv;
            const float y = allreduce16((y4[0] + y4[1]) + (y4[2] + y4[3]));
            const int bh = bh0 + (u >> 1);
            if (q == 0) ((float*)(ws + W_YRAW))[(size_t)(NPT + (bh >> 3) * 8 + s) * 512 + (bh & 7) * 64 + i] = y;
        }
    }
#pragma unroll
    for (int u = 0; u < 4; ++u) *(f32x4*)(p.out + O_SRWKV + (size_t)(bh0 + (u >> 1)) * 4096 + ((u & 1) * 32 + il) * 64 + q * 4) = S[u];
}

constexpr int CO_A1 = 0, CO_NM = 4608, CO_A3 = 6144, CO_BT = 8704, CO_KT = 11776, CO_VT = 14848, CO_GC = 17920, C_OP = 18432;
constexpr int CS_RAW = 2 * C_OP, CS_L = CS_RAW + 24576, CS_HAT = CS_L + 4352, CS_MAT = CS_HAT + 16384;
__device__ __forceinline__ bf16x8 frag_perm(const LAS bf16_t* M, int pitch, int row, int kb, int s2, int h) {
    const LAS bf16_t* q = M + row * pitch + kb + 16 * s2 + 4 * h;
    const u32x2 a = *(const LAS u32x2*)q, b = *(const LAS u32x2*)(q + 8);
    return __builtin_bit_cast(bf16x8, (u32x4){a.x, a.y, b.x, b.y});
}
__device__ __forceinline__ bf16x8 acc_frag(const f32x16& x, int s2) {
    return pack8(x[8 * s2 + 0], x[8 * s2 + 1], x[8 * s2 + 2], x[8 * s2 + 3], x[8 * s2 + 4], x[8 * s2 + 5], x[8 * s2 + 6], x[8 * s2 + 7]);
}
constexpr int PS_RAW = 0, PS_L = 24576, PS_HAT = PS_L + 4352, PS_MAT = PS_HAT + 16384, PS_OUT = PS_MAT + 5120, PS_SZ = PS_OUT + C_OP;
__device__ __forceinline__ void chunk_ops_phase(LAS unsigned char* lds_all, int bid, int nb) {
    CParams& p = kparams();
    unsigned char* ws = p.ws;
    const int tid = opaque_tid(); const int grp = tid >> 8, hid = tid & 255;
    LAS unsigned char* lds = lds_all + grp * PS_SZ;
    LAS float* RAW = (LAS float*)(lds + PS_RAW); LAS float* LP = (LAS float*)(lds + PS_L); LAS float* HAT = (LAS float*)(lds + PS_HAT); LAS float* MAT = (LAS float*)(lds + PS_MAT);
    LAS unsigned char* ob = lds + PS_OUT;
    const int npair = 4096;
    u32x4 pre[3];
    auto gl = [&](int pair) {
        const int gc = pair * 2 + grp; const int bh = gc >> 8, c = gc & 255; const int m0 = (bh >> 3) * 4096 + c * 16, hd = bh & 7;
#pragma unroll
        for (int k = 0; k < 3; ++k) { const int idx = hid + 256 * k; const int arr = idx >> 7, rem = idx & 127, t = rem >> 3, g8 = rem & 7;
            pre[k] = *(const u32x4*)((const bf16_t*)(ws + W_R + (size_t)arr * RW_SZ) + (size_t)(m0 + t) * 512 + hd * 64 + g8 * 8); }
    };
    int pair = bid;
    if (pair < npair) gl(pair);
    for (; pair < npair; pair += nb) {
        const int gc = pair * 2 + grp;
        {
#pragma unroll
            for (int k = 0; k < 3; ++k) { const int idx = hid + 256 * k; const int arr = idx >> 7, rem = idx & 127, t = rem >> 3, g8 = rem & 7;
                LAS float* d = RAW + (arr * 16 + t) * 64 + g8 * 8; const u32x4 v = pre[k];
                *(LAS f32x4*)d = (f32x4){bf_lo(v.x), bf_hi(v.x), bf_lo(v.y), bf_hi(v.y)}; *(LAS f32x4*)(d + 4) = (f32x4){bf_lo(v.z), bf_hi(v.z), bf_lo(v.w), bf_hi(v.w)}; }
            if (pair + nb < npair) gl(pair + nb);
        }
        __syncthreads();
        {
            float Lc[17]; { const int j = hid & 63; float acc = 0.f; Lc[0] = 0.f;
#pragma unroll
                for (int t = 0; t < 16; ++t) { acc += RAW[(1 * 16 + t) * 64 + j]; Lc[t + 1] = acc; } }
#pragma unroll
            for (int k = 0; k < 4; ++k) { const int e = hid + 256 * k; const int j = e & 63; const int tq = hid >> 6;
                float Lt = 0.f, Lp = 0.f;
#pragma unroll
                for (int t2 = 0; t2 < 16; ++t2) { if ((t2 & 3) == 0) {} if (t2 == tq + 4 * k) { Lt = Lc[t2 + 1]; Lp = Lc[t2]; } }
                const int t = tq + 4 * k; const float LC = Lc[16];
                const float rr = RAW[(0 * 16 + t) * 64 + j], kk = RAW[(2 * 16 + t) * 64 + j], vv = RAW[(3 * 16 + t) * 64 + j], aa = RAW[(4 * 16 + t) * 64 + j], bb = RAW[(5 * 16 + t) * 64 + j];
                const float Lm = Lc[8];
                const float ah = aa * __expf(Lp), rh = rr * __expf(Lt), en = __expf(Lm - Lt), em = __expf(-Lm), es = __expf(LC - Lt);
                LAS bf16_t* HH = (LAS bf16_t*)HAT;
                HH[t * 72 + j] = f2bf(ah * em); HH[(16 + t) * 72 + j] = f2bf(rh * em); HH[(32 + t) * 72 + j] = f2bf(bb * en); HH[(48 + t) * 72 + j] = f2bf(kk * en);
                ((LAS bf16_t*)(ob + CO_A1))[t * 72 + j] = f2bf(ah); ((LAS bf16_t*)(ob + CO_A1))[(16 + t) * 72 + j] = f2bf(rh);
                ((LAS bf16_t*)(ob + CO_BT))[j * 24 + t] = f2bf(bb * es); ((LAS bf16_t*)(ob + CO_KT))[j * 24 + t] = f2bf(kk * es); ((LAS bf16_t*)(ob + CO_VT))[j * 24 + t] = f2bf(vv);
                if (t == 15) ((LAS float*)(ob + CO_GC))[j] = __expf(LC); }
        }
        __syncthreads();
        if (hid < 64) {
            LAS const bf16_t* HH = (LAS const bf16_t*)HAT; const int r = hid & 31, h = hid >> 5;
            f32x16 D;
#pragma unroll
            for (int i2 = 0; i2 < 16; ++i2) D[i2] = 0.f;
#pragma unroll
            for (int ks = 0; ks < 4; ++ks) D = mfma32(*(const LAS bf16x8*)(HH + (32 + r) * 72 + ks * 16 + h * 8), *(const LAS bf16x8*)(HH + r * 72 + ks * 16 + h * 8), D);
            const int y = r;
#pragma unroll
            for (int reg = 0; reg < 16; ++reg) { const int x = (reg & 3) + 8 * (reg >> 2) + 4 * h;
                const int mat = (x >> 4) + 2 * (y >> 4), xx = x & 15, yy = y & 15;
                const bool nz = (y < 16) ? (xx < yy) : (xx <= yy);
                MAT[mat * 256 + xx * 16 + yy] = nz ? D[reg] : 0.f; }
        }
        __syncthreads();
        if (hid < 16) {
            const int tau = hid; float T[16];
#pragma unroll
            for (int s = 0; s < 16; ++s) { float v = (s == tau) ? 1.f : 0.f;
#pragma unroll
                for (int sg = 0; sg < s; ++sg) v += (sg >= tau) ? T[sg] * MAT[0 * 256 + sg * 16 + s] : 0.f;
                T[s] = v; }
#pragma unroll
            for (int s = 0; s < 16; ++s) MAT[4 * 256 + tau * 16 + s] = T[s];
        }
        __syncthreads();
        {
            LAS const float* TT = MAT + 4 * 256;
#pragma unroll
            for (int k = 0; k < 4; ++k) { const int e = hid + 256 * k; const int row = e >> 5, col = e & 31; float v;
                if (row < 16) v = (col < 16) ? TT[col * 16 + row] : 0.f;
                else { const int t = row - 16;
                    if (col < 16) { v = 0.f;
#pragma unroll
                        for (int s = 0; s < 16; ++s) v += MAT[2 * 256 + s * 16 + t] * TT[col * 16 + s]; }
                    else v = (col - 16 == t) ? 1.f : 0.f; }
                ((LAS bf16_t*)(ob + CO_A3))[row * 40 + col] = f2bf(v); }
#pragma unroll
            for (int k = 0; k < 2; ++k) { const int e = hid + 256 * k; const int row = e >> 4, col = e & 15;
                const float v = (row < 16) ? MAT[1 * 256 + col * 16 + row] : MAT[3 * 256 + col * 16 + (row - 16)];
                ((LAS bf16_t*)(ob + CO_NM))[row * 24 + col] = f2bf(v); }
        }
        __syncthreads();
        {
            unsigned char* dst = ws + W_COP + (size_t)gc * C_OP;
            for (int e = hid; e < C_OP / 16; e += 256) *(u32x4*)(dst + e * 16) = *(LAS const u32x4*)(ob + e * 16);
        }
    }
}

__device__ __forceinline__ void scan_chain(CParams& p, LAS unsigned char* lds, int bh) {
    unsigned char* ws = p.ws;
    const int tid = opaque_tid(), wv = __builtin_amdgcn_readfirstlane(tid >> 6), lane = tid & 63, r = lane & 31, h = lane >> 5;
    const int b = bh >> 3, hd = bh & 7, m0 = b * 4096;
    const bool comp = wv < 2; const int it = wv;
    const int hid = tid - 128;
    const unsigned char* cop = ws + W_COP + (size_t)bh * 256 * C_OP;
    f32x16 X0, X1;
#pragma unroll
    for (int i2 = 0; i2 < 16; ++i2) { X0[i2] = 0.f; X1[i2] = 0.f; }
    constexpr int nch = 256;
    u32x4 cp[3];
    auto cload = [&](int c) {
#pragma unroll
        for (int k = 0; k < 3; ++k) cp[k] = *(const u32x4*)(cop + (size_t)c * C_OP + (hid + 384 * k) * 16); };
    auto cstore = [&](int c) {
#pragma unroll
        for (int k = 0; k < 3; ++k) *(LAS u32x4*)(lds + (c & 1) * C_OP + (hid + 384 * k) * 16) = cp[k]; };
    __syncthreads();
    if (!comp) { cload(0); cstore(0); cload(1); }
    __syncthreads();
    for (int c = 0; c < nch; ++c) {
        if (!comp) { if (c + 1 < nch) { cstore(c + 1); if (c + 2 < nch) cload(c + 2); } }
        else {
            LAS const bf16_t* A1 = (LAS const bf16_t*)(lds + (c & 1) * C_OP + CO_A1); LAS const bf16_t* NM = (LAS const bf16_t*)(lds + (c & 1) * C_OP + CO_NM);
            LAS const bf16_t* A3 = (LAS const bf16_t*)(lds + (c & 1) * C_OP + CO_A3); LAS const bf16_t* BT = (LAS const bf16_t*)(lds + (c & 1) * C_OP + CO_BT);
            LAS const bf16_t* KT = (LAS const bf16_t*)(lds + (c & 1) * C_OP + CO_KT); LAS const bf16_t* VT = (LAS const bf16_t*)(lds + (c & 1) * C_OP + CO_VT);
            LAS const float* GC = (LAS const float*)(lds + (c & 1) * C_OP + CO_GC);
            const bf16x8 vfr = *(const LAS bf16x8*)(VT + (32 * it + r) * 24 + 8 * h);
            f32x16 Q;
#pragma unroll
            for (int i2 = 0; i2 < 16; ++i2) Q[i2] = 0.f;
#pragma unroll
            for (int s2 = 0; s2 < 2; ++s2) { Q = mfma32(frag_perm(A1, 72, r, 0, s2, h), acc_frag(X0, s2), Q); Q = mfma32(frag_perm(A1, 72, r, 32, s2, h), acc_frag(X1, s2), Q); }
            Q = mfma32(*(const LAS bf16x8*)(NM + r * 24 + 8 * h), vfr, Q);
            f32x16 G;
#pragma unroll
            for (int i2 = 0; i2 < 16; ++i2) G[i2] = 0.f;
#pragma unroll
            for (int s2 = 0; s2 < 2; ++s2) G = mfma32(frag_perm(A3, 40, r, 0, s2, h), acc_frag(Q, s2), G);
            float* yo = (float*)(ws + W_YRAW) + (size_t)(m0 + c * 16) * 512 + hd * 64 + 32 * it + r;
#pragma unroll
            for (int reg = 8; reg < 16; ++reg) { const int t = (reg & 3) + 8 * ((reg >> 2) - 2) + 4 * h; yo[(size_t)t * 512] = G[reg]; }
            const bf16x8 ufr = acc_frag(G, 0);
#pragma unroll
            for (int jt = 0; jt < 2; ++jt) {
                f32x16 Xn = jt == 0 ? X0 : X1;
#pragma unroll
                for (int q4 = 0; q4 < 4; ++q4) { const f32x4 gc = *(const LAS f32x4*)(GC + 32 * jt + 8 * q4 + 4 * h);
#pragma unroll
                    for (int e = 0; e < 4; ++e) Xn[4 * q4 + e] *= gc[e]; }
                Xn = mfma32(frag_perm(BT, 24, 32 * jt + r, 0, 0, h), ufr, Xn);
                Xn = mfma32(*(const LAS bf16x8*)(KT + (32 * jt + r) * 24 + 8 * h), vfr, Xn);
                if (jt == 0) X0 = Xn; else X1 = Xn;
            }
        }
        __syncthreads();
    }
    if (comp) {
        float* so = p.out + O_PRWKV + (size_t)bh * 4096 + (size_t)(32 * it + r) * 64;
#pragma unroll
        for (int jt = 0; jt < 2; ++jt)
#pragma unroll
            for (int q4 = 0; q4 < 4; ++q4) { const f32x16& Xs = jt == 0 ? X0 : X1;
                *(f32x4*)(so + 32 * jt + 8 * q4 + 4 * h) = (f32x4){Xs[4 * q4], Xs[4 * q4 + 1], Xs[4 * q4 + 2], Xs[4 * q4 + 3]}; }
    }
}

constexpr int A_KL = 0, A_VL = 9216, A_KV1 = 17920  , A_G = 35840, A_E = A_G + 16384, A_MISC = A_E + 16384, A_FIN = A_MISC + 512;
struct AttnSt { f32x16 o0, o1; float m, l; };
__device__ __forceinline__ void attn_init(AttnSt& s) {
#pragma unroll
    for (int i = 0; i < 16; ++i) { s.o0[i] = 0.f; s.o1[i] = 0.f; }
    s.m = -1e30f; s.l = 0.f;
}
__device__ __forceinline__ int keyl_of(int reg, int h) { return (reg & 3) + 8 * (reg >> 2) + 4 * h; }
__device__ __forceinline__ unsigned range_mask(int base, int h, int lo, int hi) {
    unsigned vm = 0;
#pragma unroll
    for (int reg = 0; reg < 16; ++reg) { const int k = base + keyl_of(reg, h); vm |= (k >= lo && k <= hi) ? (1u << reg) : 0u; }
    return vm;
}
__device__ __forceinline__ f32x16 qk_sub(const LAS bf16_t* Kl, int krow0, const bf16x8 (&Qf)[4], int r, int h) {
    f32x16 s;
#pragma unroll
    for (int i = 0; i < 16; ++i) s[i] = 0.f;
#pragma unroll
    for (int ks = 0; ks < 4; ++ks) { const bf16x8 kf = *(const LAS bf16x8*)(Kl + (krow0 + r) * 72 + ks * 16 + h * 8); s = mfma32(kf, Qf[ks], s); }
    return s;
}
__device__ __forceinline__ void sm_update(f32x16& s, AttnSt& st, unsigned vm) {
    const bool full = (__ballot(vm != 0xffffu) == 0ull);
    float mx = -1e30f;
    if (full) {
#pragma unroll
        for (int reg = 0; reg < 16; ++reg) mx = fmaxf(mx, s[reg]);
    } else {
#pragma unroll
        for (int reg = 0; reg < 16; ++reg) mx = ((vm >> reg) & 1u) ? fmaxf(mx, s[reg]) : mx;
    }
    mx = fmaxf(mx, __shfl_xor(mx, 32));
    if (__ballot(mx > st.m + 8.0f) != 0ull) {
        const float mnew = fmaxf(st.m, mx); const float alpha = __builtin_amdgcn_exp2f(st.m - mnew);
        st.l *= alpha; st.m = mnew; st.o0 = st.o0 * alpha; st.o1 = st.o1 * alpha;
    }
    float sum = 0.f; const float mref = st.m;
    if (full) {
#pragma unroll
        for (int reg = 0; reg < 16; ++reg) { const float pv = __builtin_amdgcn_exp2f(s[reg] - mref); s[reg] = pv; sum += pv; }
    } else {
#pragma unroll
        for (int reg = 0; reg < 16; ++reg) { const float pv = ((vm >> reg) & 1u) ? __builtin_amdgcn_exp2f(s[reg] - mref) : 0.f; s[reg] = pv; sum += pv; }
    }
    st.l += sum;
}
__device__ __forceinline__ void pv_sub(const LAS bf16_t* Vl, int kcol0, const f32x16& pr, AttnSt& st, int r, int h) {
#pragma unroll
    for (int s2 = 0; s2 < 2; ++s2) {
        const bf16x8 pf = pack8(pr[8 * s2 + 0], pr[8 * s2 + 1], pr[8 * s2 + 2], pr[8 * s2 + 3], pr[8 * s2 + 4], pr[8 * s2 + 5], pr[8 * s2 + 6], pr[8 * s2 + 7]);
#pragma unroll
        for (int dt = 0; dt < 2; ++dt) {
            const LAS bf16_t* vp = Vl + (dt * 32 + r) * 68 + kcol0 + 16 * s2 + 4 * h;
            const u32x2 a = *(const LAS u32x2*)vp, b = *(const LAS u32x2*)(vp + 8);
            const bf16x8 vf = __builtin_bit_cast(bf16x8, (u32x4){a.x, a.y, b.x, b.y});
            if (dt == 0) st.o0 = mfma32(vf, pf, st.o0); else st.o1 = mfma32(vf, pf, st.o1);
        }
    }
}
__device__ __forceinline__ float xhalf_max(float x) {
    const auto r2 = __builtin_amdgcn_permlane32_swap(__float_as_uint(x), __float_as_uint(x), false, false);
    return fmaxf(__uint_as_float(r2[0]), __uint_as_float(r2[1]));
}
__device__ __forceinline__ void qk_tile(const LAS bf16_t* Kl, const bf16x8 (&Qf)[4], int r, int h, f32x16& s0, f32x16& s1) {
#pragma unroll
    for (int i = 0; i < 16; ++i) { s0[i] = 0.f; s1[i] = 0.f; }
#pragma unroll
    for (int ks = 0; ks < 4; ++ks) {
        const bf16x8 k0 = *(const LAS bf16x8*)(Kl + r * 72 + ks * 16 + h * 8), k1 = *(const LAS bf16x8*)(Kl + (32 + r) * 72 + ks * 16 + h * 8);
        s0 = mfma32(k0, Qf[ks], s0); s1 = mfma32(k1, Qf[ks], s1);
    }
}
__device__ __forceinline__ void sm_update2(f32x16& s0, f32x16& s1, AttnSt& st, unsigned vm0, unsigned vm1) {
    const bool full = (__ballot((vm0 & vm1) != 0xffffu) == 0ull);
    float mx = -1e30f;
    if (full) {
#pragma unroll
        for (int reg = 0; reg < 16; ++reg) mx = fmaxf(mx, fmaxf(s0[reg], s1[reg]));
    } else {
#pragma unroll
        for (int reg = 0; reg < 16; ++reg) { mx = ((vm0 >> reg) & 1u) ? fmaxf(mx, s0[reg]) : mx; mx = ((vm1 >> reg) & 1u) ? fmaxf(mx, s1[reg]) : mx; }
    }
    mx = xhalf_max(mx);
    if (__ballot(mx > st.m + 8.0f) != 0ull) {
        const float mnew = fmaxf(st.m, mx); const float alpha = __builtin_amdgcn_exp2f(st.m - mnew);
        st.l *= alpha; st.m = mnew; st.o0 = st.o0 * alpha; st.o1 = st.o1 * alpha;
    }
    float sum = 0.f; const float mref = st.m;
    if (full) {
#pragma unroll
        for (int reg = 0; reg < 16; ++reg) { const float p0 = __builtin_amdgcn_exp2f(s0[reg] - mref), p1 = __builtin_amdgcn_exp2f(s1[reg] - mref); s0[reg] = p0; s1[reg] = p1; sum += p0 + p1; }
    } else {
#pragma unroll
        for (int reg = 0; reg < 16; ++reg) {
            const float p0 = ((vm0 >> reg) & 1u) ? __builtin_amdgcn_exp2f(s0[reg] - mref) : 0.f, p1 = ((vm1 >> reg) & 1u) ? __builtin_amdgcn_exp2f(s1[reg] - mref) : 0.f;
            s0[reg] = p0; s1[reg] = p1; sum += p0 + p1; }
    }
    st.l += sum;
}
__device__ __forceinline__ void attn_tile(const LAS bf16_t* Kl, const LAS bf16_t* Vl, const bf16x8 (&Qf)[4], AttnSt& st, unsigned vm0, unsigned vm1, int r, int h) {
    if (__ballot((vm0 | vm1) != 0u) == 0ull) return;
    f32x16 s0, s1;
    qk_tile(Kl, Qf, r, h, s0, s1);
    sm_update2(s0, s1, st, vm0, vm1);
    pv_sub(Vl, 0, s0, st, r, h); pv_sub(Vl, 32, s1, st, r, h);
}
struct StgB { u32x4 k, v; };
__device__ __forceinline__ void ldg_k(StgB& s, const bf16_t* Kg, int tid) { s.k = *(const u32x4*)(Kg + (tid >> 3) * 64 + (tid & 7) * 8); }
__device__ __forceinline__ void ldg_vt(StgB& s, const bf16_t* Vg, int Tp, int tid) { s.v = *(const u32x4*)(Vg + (size_t)(tid >> 3) * Tp + (tid & 7) * 8); }
__device__ __forceinline__ void sts_k(LAS bf16_t* Kl, const StgB& s, int tid) { *(LAS u32x4*)(Kl + (tid >> 3) * 72 + (tid & 7) * 8) = s.k; }
__device__ __forceinline__ void sts_vt(LAS bf16_t* Vl, const StgB& s, int tid) { LAS u32x2* d = (LAS u32x2*)(Vl + (tid >> 3) * 68 + (tid & 7) * 8); d[0] = (u32x2){s.v.x, s.v.y}; d[1] = (u32x2){s.v.z, s.v.w}; }
struct StgF { f32x4 k0, k1, v0, v1; };
__device__ __forceinline__ void ldg_f32(StgF& s, const float* rowp, int g, int tid) {
    const f32x4 z = (f32x4){0.f, 0.f, 0.f, 0.f}; s.k0 = z; s.k1 = z; s.v0 = z; s.v1 = z;
    if (rowp) { const float* q = rowp + g * 64 + (tid & 7) * 8; s.k0 = *(const f32x4*)q; s.k1 = *(const f32x4*)(q + 4); s.v0 = *(const f32x4*)(q + 128); s.v1 = *(const f32x4*)(q + 132); }
}
__device__ __forceinline__ void sts_f32(LAS bf16_t* Kl, LAS bf16_t* Vl, const StgF& s, int tid) {
    const int key = tid >> 3, part = tid & 7;
    u32x4 w; w.x = cvt_pk_bf16(s.k0[0], s.k0[1]); w.y = cvt_pk_bf16(s.k0[2], s.k0[3]); w.z = cvt_pk_bf16(s.k1[0], s.k1[1]); w.w = cvt_pk_bf16(s.k1[2], s.k1[3]);
    *(LAS u32x4*)(Kl + key * 72 + part * 8) = w;
#pragma unroll
    for (int j = 0; j < 4; ++j) { Vl[(part * 8 + j) * 68 + key] = f2bf(s.v0[j]); Vl[(part * 8 + 4 + j) * 68 + key] = f2bf(s.v1[j]); }
}
__device__ __forceinline__ void cmp_stats(const f32x16& s, unsigned vm, float& m1, float& l1) {
    float mx = -1e30f;
#pragma unroll
    for (int reg = 0; reg < 16; ++reg) mx = ((vm >> reg) & 1u) ? fmaxf(mx, s[reg]) : mx;
    mx = fmaxf(mx, __shfl_xor(mx, 32));
    const float mnew = fmaxf(m1, mx); float sum = 0.f;
#pragma unroll
    for (int reg = 0; reg < 16; ++reg) sum += ((vm >> reg) & 1u) ? __builtin_amdgcn_exp2f(s[reg] - mnew) : 0.f;
    l1 = l1 * __builtin_amdgcn_exp2f(m1 - mnew) + sum; m1 = mnew;
}
__device__ __forceinline__ void cmp_probs(f32x16& s, unsigned vm, float m1, float inv, LAS float* Gl, LAS float* El, int tlrow, int jbase, int r, int h) {
#pragma unroll
    for (int reg = 0; reg < 16; ++reg) s[reg] = ((vm >> reg) & 1u) ? __builtin_amdgcn_exp2f(s[reg] - m1) * inv : 0.f;
#pragma unroll
    for (int q4 = 0; q4 < 4; ++q4) {
        const float p0 = allreduce4(s[4 * q4]), p1 = allreduce4(s[4 * q4 + 1]), p2 = allreduce4(s[4 * q4 + 2]), p3 = allreduce4(s[4 * q4 + 3]);
        if ((r & 3) == 0) { const int j = jbase + 2 * q4 + h; Gl[tlrow * 64 + j] = (p0 + p1) + (p2 + p3); El[tlrow * 64 + j] = p3; }
    }
}
__device__ __forceinline__ unsigned long long topk_mask(const LAS float* Gl, const LAS float* El, int tlrow, int cur, int lane) {
    if (cur < 16) return (1ull << (cur + 1)) - 1ull;
    const int j = lane;
    const float imp = Gl[tlrow * 64 + j] + (j > 0 ? El[tlrow * 64 + j - 1] : 0.f);
    int rank = 0;
    for (int jp = 1; jp <= cur - 2; ++jp) { const float v = __int_as_float(__builtin_amdgcn_readlane(__float_as_int(imp), jp)); rank += ((v > imp) || (v == imp && jp < j)) ? 1 : 0; }
    const bool sel = (j >= 1 && j <= cur - 2 && rank < 13) || j == 0 || j == cur || j == cur - 1;
    return __ballot(sel);
}
__device__ __forceinline__ void attn_fold(LAS float* fin, int tid, AttnSt& st, float gate, bool normalised, int mode) {
    float sc = gate;
    if (!normalised) { const float lt = st.l + __shfl_xor(st.l, 32); sc = lt > 0.f ? gate / lt : 0.f; }
#pragma unroll
    for (int reg = 0; reg < 16; ++reg) {
        float a = st.o0[reg] * sc, b = st.o1[reg] * sc;
        if (mode != 0) { a += fin[reg * 512 + tid]; b += fin[(16 + reg) * 512 + tid]; }
        if (mode == 2) { st.o0[reg] = a; st.o1[reg] = b; } else { fin[reg * 512 + tid] = a; fin[(16 + reg) * 512 + tid] = b; }
    }
}
__device__ __forceinline__ void attn_store(CParams& p, int m, int head, const f32x16& f0, const f32x16& f1, int h) {
    bf16_t* yo = (bf16_t*)(p.ws + W_YCAT) + (size_t)m * 1024 + 512 + head * 64;
#pragma unroll
    for (int dt = 0; dt < 2; ++dt)
#pragma unroll
        for (int q4 = 0; q4 < 4; ++q4) {
            f32x4 v;
#pragma unroll
            for (int j = 0; j < 4; ++j) { const int reg = 4 * q4 + j; v[j] = dt == 0 ? f0[reg] : f1[reg]; }
            *(u32x2*)(yo + dt * 32 + 8 * q4 + 4 * h) = pack4(v);
        }
}

__device__ __forceinline__ void attn_prompt_tile(CParams& p, LAS unsigned char* lds, int item) {
    unsigned char* ws = p.ws;
    const int tid = opaque_tid(), wv = __builtin_amdgcn_readfirstlane(tid >> 6), lane = tid & 63, r = lane & 31, h = lane >> 5;
    const int T = 63 - (item >> 3), bg = item & 7, b = bg >> 1, g = bg & 1;
    const int tl = wv * 8 + (r >> 2), head = g * 4 + (r & 3);
    const int pos = 64 * T + tl, m = b * 4096 + pos;
    LAS bf16_t* Kl = (LAS bf16_t*)(lds + A_KL); LAS bf16_t* Vl = (LAS bf16_t*)(lds + A_VL); LAS float* Gl = (LAS float*)(lds + A_G); LAS float* El = (LAS float*)(lds + A_E);
    __syncthreads();
    for (int i = tid; i < 8192; i += NTHR) Gl[i] = 0.f;
    bf16x8 Qf[4];
#pragma unroll
    for (int ks = 0; ks < 4; ++ks) Qf[ks] = *(const bf16x8*)((const bf16_t*)(ws + W_QC) + (size_t)m * 512 + head * 64 + ks * 16 + h * 8);
    const int climit = pos >= 31 ? ((pos - 31) >> 4) : -1;
    const int nct = (4 * T + 3 + 63) >> 6;
    const bf16_t* Kc = (const bf16_t*)(ws + W_KCP) + (size_t)bg * 256 * 64; const bf16_t* Vc = (const bf16_t*)(ws + W_VCPT) + (size_t)bg * 64 * 256;
    float m1 = -1e30f, l1 = 0.f;
    StgB sg;
    ldg_k(sg, Kc, tid);
    for (int tile = 0; tile < nct; ++tile) {
        __syncthreads(); sts_k(Kl, sg, tid); __syncthreads();
        if (tile + 1 < nct) ldg_k(sg, Kc + (size_t)(tile + 1) * 64 * 64, tid);
#pragma unroll
        for (int sub = 0; sub < 2; ++sub) { const f32x16 s = qk_sub(Kl, sub * 32, Qf, r, h); cmp_stats(s, range_mask(tile * 64 + sub * 32, h, 0, climit), m1, l1); }
    }
    const float l1t = l1 + __shfl_xor(l1, 32); const float inv1 = l1t > 0.f ? 1.0f / l1t : 0.f;
    const float* gn = (const float*)(ws + W_GN) + (size_t)m * 24 + head * 3;
    const float gt0 = gn[0], gt1 = gn[1], gt2 = gn[2];
    LAS float* fin = (LAS float*)(lds + A_FIN);
    AttnSt oc; attn_init(oc);
    ldg_k(sg, Kc, tid); ldg_vt(sg, Vc, 256, tid);
    for (int tile = 0; tile < nct; ++tile) {
        __syncthreads(); sts_k(Kl, sg, tid); sts_vt(Vl, sg, tid); __syncthreads();
        if (tile + 1 < nct) { ldg_k(sg, Kc + (size_t)(tile + 1) * 64 * 64, tid); ldg_vt(sg, Vc + (tile + 1) * 64, 256, tid); }
#pragma unroll
        for (int sub = 0; sub < 2; ++sub) {
            f32x16 s = qk_sub(Kl, sub * 32, Qf, r, h);
            cmp_probs(s, range_mask(tile * 64 + sub * 32, h, 0, climit), m1, inv1, Gl, El, tl, tile * 16 + sub * 8, r, h);
            pv_sub(Vl, sub * 32, s, oc, r, h);
        }
    }
    attn_fold(fin, tid, oc, gt0, true, 0);
    __syncthreads();
    unsigned long long mymask = 0ull, anymask = 0ull;
    for (int k = 0; k < 8; ++k) { const unsigned long long mk = topk_mask(Gl, El, wv * 8 + k, T, lane); anymask |= mk; if ((r >> 2) == k) mymask = mk; }
#pragma unroll
    for (int ks = 0; ks < 4; ++ks) Qf[ks] = *(const bf16x8*)((const bf16_t*)(ws + W_QR) + (size_t)m * 512 + head * 64 + ks * 16 + h * 8);
    attn_init(oc);
    {
        const bf16_t* Kg = (const bf16_t*)(ws + W_KS) + (size_t)bg * 4096 * 64; const bf16_t* Vg = (const bf16_t*)(ws + W_VST) + (size_t)bg * 64 * 4096;
        ldg_k(sg, Kg, tid); ldg_vt(sg, Vg, 4096, tid);
        __syncthreads(); sts_k(Kl, sg, tid); sts_vt(Vl, sg, tid);
        if (T >= 1) { ldg_k(sg, Kg + (size_t)64 * 64, tid); ldg_vt(sg, Vg + 64, 4096, tid); }
        for (int j = 0; j <= T; ++j) {
            LAS bf16_t* Kc_ = (LAS bf16_t*)(lds + (j & 1) * A_KV1); LAS bf16_t* Vc_ = Kc_ + 4608;
            LAS bf16_t* Kn_ = (LAS bf16_t*)(lds + ((j + 1) & 1) * A_KV1); LAS bf16_t* Vn_ = Kn_ + 4608;
            __syncthreads();
            if (j < T) { sts_k(Kn_, sg, tid); sts_vt(Vn_, sg, tid); }
            if (j + 1 < T) { ldg_k(sg, Kg + (size_t)(j + 2) * 64 * 64, tid); ldg_vt(sg, Vg + (j + 2) * 64, 4096, tid); }
            if ((anymask >> j) & 1ull) {
                const bool en = (mymask >> j) & 1ull;
                const unsigned vm0 = en ? (j < T ? 0xffffu : range_mask(j * 64, h, -1, pos)) : 0u, vm1 = en ? (j < T ? 0xffffu : range_mask(j * 64 + 32, h, -1, pos)) : 0u;
                attn_tile(Kc_, Vc_, Qf, oc, vm0, vm1, r, h);
            }
        }
    }
    attn_fold(fin, tid, oc, gt1, false, 1);
    attn_init(oc);
    {
        const bf16_t* Kg = (const bf16_t*)(ws + W_KW) + (size_t)bg * 4096 * 64; const bf16_t* Vg = (const bf16_t*)(ws + W_VWT) + (size_t)bg * 64 * 4096;
        const int j0 = (T > 8 ? T - 8 : 0);
        ldg_k(sg, Kg + (size_t)j0 * 64 * 64, tid); ldg_vt(sg, Vg + j0 * 64, 4096, tid);
        __syncthreads(); sts_k(Kl, sg, tid); sts_vt(Vl, sg, tid);
        if (j0 < T) { ldg_k(sg, Kg + (size_t)(j0 + 1) * 64 * 64, tid); ldg_vt(sg, Vg + (j0 + 1) * 64, 4096, tid); }
        for (int j = j0; j <= T; ++j) {
            const int pb = (j - j0) & 1;
            LAS bf16_t* Kc_ = (LAS bf16_t*)(lds + pb * A_KV1); LAS bf16_t* Vc_ = Kc_ + 4608;
            LAS bf16_t* Kn_ = (LAS bf16_t*)(lds + (pb ^ 1) * A_KV1); LAS bf16_t* Vn_ = Kn_ + 4608;
            __syncthreads();
            if (j < T) { sts_k(Kn_, sg, tid); sts_vt(Vn_, sg, tid); }
            if (j + 1 < T) { ldg_k(sg, Kg + (size_t)(j + 2) * 64 * 64, tid); ldg_vt(sg, Vg + (j + 2) * 64, 4096, tid); }
            const bool inner = (j > T - 8 && j < T);
            const unsigned vm0 = inner ? 0xffffu : range_mask(j * 64, h, pos - 511, pos), vm1 = inner ? 0xffffu : range_mask(j * 64 + 32, h, pos - 511, pos);
            attn_tile(Kc_, Vc_, Qf, oc, vm0, vm1, r, h);
        }
    }
    attn_fold(fin, tid, oc, gt2, false, 2);
    attn_store(p, m, head, oc.o0, oc.o1, h);
}

__device__ __forceinline__ void attn_sample_unit(CParams& p, LAS unsigned char* lds, int unit) {
    unsigned char* ws = p.ws;
    const int tid = opaque_tid(), wv = __builtin_amdgcn_readfirstlane(tid >> 6), lane = tid & 63, r = lane & 31, h = lane >> 5;
    const int seq = unit >> 1, g = unit & 1; const bool act = (wv == 0);
    const int tq = r >> 2, head = g * 4 + (r & 3), pos = 2048 + tq, m = NPT + seq * 8 + tq;
    LAS bf16_t* Kl = (LAS bf16_t*)(lds + A_KL); LAS bf16_t* Vl = (LAS bf16_t*)(lds + A_VL); LAS float* Gl = (LAS float*)(lds + A_G); LAS float* El = (LAS float*)(lds + A_E);
    LAS unsigned* misc = (LAS unsigned*)(lds + A_MISC);
    __syncthreads();
    for (int i = tid; i < 8192; i += NTHR) Gl[i] = 0.f;
    bf16x8 Qf[4];
#pragma unroll
    for (int ks = 0; ks < 4; ++ks) Qf[ks] = *(const bf16x8*)((const bf16_t*)(ws + W_QC) + (size_t)m * 512 + head * 64 + ks * 16 + h * 8);
    const bf16_t* Kc = (const bf16_t*)(ws + W_KCS) + (size_t)unit * 128 * 64; const bf16_t* Vc = (const bf16_t*)(ws + W_VCST) + (size_t)unit * 64 * 128;
    float m1 = -1e30f, l1 = 0.f;
    StgB sg;
    for (int tile = 0; tile < 2; ++tile) {
        ldg_k(sg, Kc + (size_t)tile * 64 * 64, tid);
        __syncthreads(); sts_k(Kl, sg, tid); __syncthreads();
        if (act) {
#pragma unroll
            for (int sub = 0; sub < 2; ++sub) { const f32x16 s = qk_sub(Kl, sub * 32, Qf, r, h); cmp_stats(s, range_mask(tile * 64 + sub * 32, h, 0, 126), m1, l1); }
        }
    }
    const float l1t = l1 + __shfl_xor(l1, 32); const float inv1 = l1t > 0.f ? 1.0f / l1t : 0.f;
    const float* gn = (const float*)(ws + W_GN) + (size_t)m * 24 + head * 3;
    const float gt0 = gn[0], gt1 = gn[1], gt2 = gn[2];
    LAS float* fin = (LAS float*)(lds + A_FIN);
    AttnSt oc; attn_init(oc);
    for (int tile = 0; tile < 2; ++tile) {
        ldg_k(sg, Kc + (size_t)tile * 64 * 64, tid); ldg_vt(sg, Vc + tile * 64, 128, tid);
        __syncthreads(); sts_k(Kl, sg, tid); sts_vt(Vl, sg, tid); __syncthreads();
        if (act) {
#pragma unroll
            for (int sub = 0; sub < 2; ++sub) {
                f32x16 s = qk_sub(Kl, sub * 32, Qf, r, h);
                cmp_probs(s, range_mask(tile * 64 + sub * 32, h, 0, 126), m1, inv1, Gl, El, tq, tile * 16 + sub * 8, r, h);
                pv_sub(Vl, sub * 32, s, oc, r, h);
            }
        }
    }
    __syncthreads();
    if (act) {
        unsigned long long anym = 0ull;
        for (int k = 0; k < 8; ++k) { const unsigned long long mk = topk_mask(Gl, El, k, 32, lane); anym |= mk; if (lane == 0) { misc[2 * k] = (unsigned)mk; misc[2 * k + 1] = (unsigned)(mk >> 32); } }
        if (lane == 0) { misc[16] = (unsigned)anym; misc[17] = (unsigned)(anym >> 32); }
    }
    __syncthreads();
    const unsigned long long anymask = (unsigned long long)misc[16] | ((unsigned long long)misc[17] << 32);
    const unsigned long long mymask = (unsigned long long)misc[2 * tq] | ((unsigned long long)misc[2 * tq + 1] << 32);
#pragma unroll
    for (int ks = 0; ks < 4; ++ks) Qf[ks] = *(const bf16x8*)((const bf16_t*)(ws + W_QR) + (size_t)m * 512 + head * 64 + ks * 16 + h * 8);
    const int* pt = (const int*)p.in[7] + seq * 16;
    __syncthreads();
    LAS bf16_t* Kw = (LAS bf16_t*)(lds + wv * 17920); LAS bf16_t* Vw = Kw + 4608;
    AttnSt os, ow; attn_init(os); attn_init(ow);
    auto slc_row = [&](int j, int key) -> const float* {
        if (j < 32) return p.in[3] + ((size_t)pt[j >> 1] * 128 + (j & 1) * 64 + key) * 256;
        return key < 8 ? p.out + O_SSLC + ((size_t)seq * 8 + key) * 256 : nullptr;
    };
    auto win_row = [&](int wt, int key) -> const float* {
        const int idx = wt * 64 + key;
        return idx < 512 ? p.in[4] + ((size_t)seq * 512 + idx) * 256 : (idx < 520 ? p.out + O_SWIN + ((size_t)seq * 512 + 504 + (idx - 512)) * 256 : nullptr);
    };
    auto stage_tile = [&](bool is_win, int tix) {
        f32x4 kr[2][4], vr[2][4];
        auto ld = [&](int pass, int bufi) {
            const int key = pass * 16 + (lane >> 2); const float* rp = is_win ? win_row(tix, key) : slc_row(tix, key);
#pragma unroll
            for (int u = 0; u < 4; ++u) { kr[bufi][u] = (f32x4){0.f, 0.f, 0.f, 0.f}; vr[bufi][u] = kr[bufi][u]; }
            if (rp) { const float* q0 = rp + g * 64 + (lane & 3) * 16;
#pragma unroll
                for (int u = 0; u < 4; ++u) { kr[bufi][u] = *(const f32x4*)(q0 + u * 4); vr[bufi][u] = *(const f32x4*)(q0 + 128 + u * 4); } }
        };
        auto st = [&](int pass, int bufi) {
            const int key = pass * 16 + (lane >> 2), d0 = (lane & 3) * 16;
            u32x4 w0, w1;
            w0.x = cvt_pk_bf16(kr[bufi][0][0], kr[bufi][0][1]); w0.y = cvt_pk_bf16(kr[bufi][0][2], kr[bufi][0][3]); w0.z = cvt_pk_bf16(kr[bufi][1][0], kr[bufi][1][1]); w0.w = cvt_pk_bf16(kr[bufi][1][2], kr[bufi][1][3]);
            w1.x = cvt_pk_bf16(kr[bufi][2][0], kr[bufi][2][1]); w1.y = cvt_pk_bf16(kr[bufi][2][2], kr[bufi][2][3]); w1.z = cvt_pk_bf16(kr[bufi][3][0], kr[bufi][3][1]); w1.w = cvt_pk_bf16(kr[bufi][3][2], kr[bufi][3][3]);
            *(LAS u32x4*)(Kw + key * 72 + d0) = w0; *(LAS u32x4*)(Kw + key * 72 + d0 + 8) = w1;
#pragma unroll
            for (int u = 0; u < 4; ++u)
#pragma unroll
                for (int e = 0; e < 4; ++e) Vw[(d0 + u * 4 + e) * 68 + key] = f2bf(vr[bufi][u][e]);
        };
        ld(0, 0); ld(1, 1); st(0, 0); ld(2, 0); st(1, 1); ld(3, 1); st(2, 0); st(3, 1);
    };
    int nlist = 0;
    {
        unsigned long long rem = anymask & 0x1FFFFFFFFull;
        while (rem) {
            const int j = __builtin_ctzll(rem); rem &= rem - 1ull;
            if ((nlist & 7) == wv) {
                stage_tile(false, j);
                const bool en = (mymask >> j) & 1ull;
                const unsigned vm0 = en ? (j < 32 ? 0xffffu : range_mask(j * 64, h, -1, pos)) : 0u, vm1 = en ? (j < 32 ? 0xffffu : range_mask(j * 64 + 32, h, -1, pos)) : 0u;
                attn_tile(Kw, Vw, Qf, os, vm0, vm1, r, h);
            }
            ++nlist;
        }
    }
    for (int wt = 0; wt < 9; ++wt, ++nlist) {
        if ((nlist & 7) == wv) {
            stage_tile(true, wt);
            const bool inner = (wt > 0 && wt < 8);
            const unsigned vm0 = inner ? 0xffffu : range_mask(wt * 64, h, tq + 1, 512 + tq), vm1 = inner ? 0xffffu : range_mask(wt * 64 + 32, h, tq + 1, 512 + tq);
            attn_tile(Kw, Vw, Qf, ow, vm0, vm1, r, h);
        }
    }
    __syncthreads();
    LAS float* part = (LAS float*)lds;
    {
        LAS float* ps = part + (size_t)(0 * 8 + wv) * 34 * 64 + lane; LAS float* pw = part + (size_t)(1 * 8 + wv) * 34 * 64 + lane;
#pragma unroll
        for (int reg = 0; reg < 16; ++reg) { ps[reg * 64] = os.o0[reg]; ps[(16 + reg) * 64] = os.o1[reg]; pw[reg * 64] = ow.o0[reg]; pw[(16 + reg) * 64] = ow.o1[reg]; }
        ps[32 * 64] = os.m; ps[33 * 64] = os.l; pw[32 * 64] = ow.m; pw[33 * 64] = ow.l;
    }
    __syncthreads();
    if (act) {
        f32x16 f0 = oc.o0 * gt0, f1 = oc.o1 * gt0;
#pragma unroll
        for (int stt = 0; stt < 2; ++stt) {
            LAS const float* pb = part + (size_t)(stt * 8) * 34 * 64 + lane;
            float M = -1e30f;
#pragma unroll
            for (int w = 0; w < 8; ++w) M = fmaxf(M, pb[(size_t)w * 34 * 64 + 32 * 64]);
            float L = 0.f; f32x16 a0, a1;
#pragma unroll
            for (int reg = 0; reg < 16; ++reg) { a0[reg] = 0.f; a1[reg] = 0.f; }
#pragma unroll
            for (int w = 0; w < 8; ++w) {
                LAS const float* pq = pb + (size_t)w * 34 * 64; const float sc = __builtin_amdgcn_exp2f(pq[32 * 64] - M);
                L += pq[33 * 64] * sc;
#pragma unroll
                for (int reg = 0; reg < 16; ++reg) { a0[reg] += pq[reg * 64] * sc; a1[reg] += pq[(16 + reg) * 64] * sc; }
            }
            const float Lt = L + __shfl_xor(L, 32); const float gs = (Lt > 0.f) ? (stt == 0 ? gt1 : gt2) / Lt : 0.f;
            f0 = f0 + a0 * gs; f1 = f1 + a1 * gs;
        }
        attn_store(p, m, head, f0, f1, h);
    }
}

__device__ __forceinline__ void phase3(LAS unsigned char* lds, int bid, int nb) {
    CParams& p = kparams();
    LAS unsigned* slot = (LAS unsigned*)(lds + LDS_BYTES - 64);
    unsigned* ctr = (unsigned*)(p.ws + W_BAR + 3456 * 4);
    for (;;) {
        __syncthreads();
        if (threadIdx.x == 0) *slot = atomicAdd(ctr, 1u);
        __syncthreads();
        const int item = __builtin_amdgcn_readfirstlane((int)*slot);
        if (item >= 32 + 512 + 256 + 512) break;
        if (item < 32) scan_chain(p, lds, item);
        else if (item < 544) attn_prompt_tile(p, lds, item - 32);
        else if (item < 800) attn_sample_unit(p, lds, item - 544);
        else scan_sample4(p, lds, item - 800);
    }
}

struct EpiG3 {
    static constexpr bool AFTER_DRAIN = false, HAS_MID = true; static constexpr int MID_T = 8;
    unsigned char* ws;
    __device__ __forceinline__ void mid(f32x4 (&acc)[2][2][4][2], const Unit& u, int wr, int wc, int fr, int fq) const {
#pragma unroll
        for (int ai = 0; ai < 2; ++ai)
#pragma unroll
            for (int m = 0; m < 4; ++m) { const size_t row = (size_t)u.pm * 256 + ai * 128 + wr * 64 + m * 16 + fr; const bf16_t* gp = (const bf16_t*)(ws + W_GATES) + row * 2048;
#pragma unroll
                for (int bj = 0; bj < 2; ++bj)
#pragma unroll
                    for (int n = 0; n < 2; ++n) { const int col = u.pn * 256 + bj * 128 + wc * 32 + n * 16 + fq * 4; acc[ai][bj][m][n] = acc[ai][bj][m][n] * ld_bf4(gp + col); } }
    }
    __device__ __forceinline__ void operator()(const f32x4 (&acc)[2][2][4][2], const Unit& u, int wr, int wc, int fr, int fq) const {
        u32x2 gv[2][4][2][2];
#pragma unroll
        for (int ai = 0; ai < 2; ++ai)
#pragma unroll
            for (int m = 0; m < 4; ++m) { const size_t row = (size_t)u.pm * 256 + ai * 128 + wr * 64 + m * 16 + fr; const bf16_t* gp = (const bf16_t*)(ws + W_GATES) + row * 2048;
#pragma unroll
                for (int bj = 0; bj < 2; ++bj)
#pragma unroll
                    for (int n = 0; n < 2; ++n) { const int col = u.pn * 256 + bj * 128 + wc * 32 + n * 16 + fq * 4; gv[ai][m][bj][n] = *(const u32x2*)(gp + 1024 + col); } }
#pragma unroll
        for (int ai = 0; ai < 2; ++ai)
#pragma unroll
            for (int m = 0; m < 4; ++m) { const size_t row = (size_t)u.pm * 256 + ai * 128 + wr * 64 + m * 16 + fr;
#pragma unroll
                for (int bj = 0; bj < 2; ++bj)
#pragma unroll
                    for (int n = 0; n < 2; ++n) { const int col = u.pn * 256 + bj * 128 + wc * 32 + n * 16 + fq * 4; const u32x2 g = gv[ai][m][bj][n];
                        *(u32x2*)((bf16_t*)(ws + W_MERGED) + row * 1024 + col) = pack4(acc[ai][bj][m][n] * (f32x4){bf_lo(g.x), bf_hi(g.x), bf_lo(g.y), bf_hi(g.y)}); } }
    }
};
struct EpiG4 {
    static constexpr bool AFTER_DRAIN = false, HAS_MID = false; static constexpr int MID_T = 0;
    unsigned char* ws; const float* xp; const float* xs;
    __device__ __forceinline__ void mid(f32x4 (&)[2][2][4][2], const Unit&, int, int, int, int) const {}
    __device__ __forceinline__ void operator()(const f32x4 (&acc)[2][2][4][2], const Unit& u, int wr, int wc, int fr, int fq) const {
#pragma unroll
        for (int ai = 0; ai < 2; ++ai) {
            f32x4 xv[4][2][2];
#pragma unroll
            for (int m = 0; m < 4; ++m) { const size_t row = (size_t)u.pm * 256 + ai * 128 + wr * 64 + m * 16 + fr; const float* xr = row < NPT ? xp + row * 1024 : xs + (row - NPT) * 1024;
#pragma unroll
                for (int bj = 0; bj < 2; ++bj)
#pragma unroll
                    for (int n = 0; n < 2; ++n) xv[m][bj][n] = *(const f32x4*)(xr + u.pn * 256 + bj * 128 + wc * 32 + n * 16 + fq * 4); }
            __builtin_amdgcn_sched_barrier(0);
#pragma unroll
            for (int m = 0; m < 4; ++m) { const size_t row = (size_t)u.pm * 256 + ai * 128 + wr * 64 + m * 16 + fr; float ss = 0.f;
#pragma unroll
                for (int bj = 0; bj < 2; ++bj) { u32x2 pk[2];
#pragma unroll
                    for (int n = 0; n < 2; ++n) {
                        const f32x4 x2 = xv[m][bj][n] + acc[ai][bj][m][n];
                        ss += x2[0] * x2[0] + x2[1] * x2[1] + x2[2] * x2[2] + x2[3] * x2[3];
                        pk[n] = pack4(x2); }
                    *(u32x4*)((bf16_t*)(ws + W_X2) + row * 1024 + u.pn * 256 + bj * 128 + wc * 32 + col8_of(fq)) = widen16(pk[0], pk[1]); }
                ss += __shfl_xor(ss, 16); ss += __shfl_xor(ss, 32);
                if (fq == 0) atomicAdd((float*)(ws + W_RS1) + row, ss); }
            __builtin_amdgcn_sched_barrier(0);
        }
    }
};
struct EpiG5 {
    static constexpr bool AFTER_DRAIN = false, HAS_MID = false; static constexpr int MID_T = 0;
    unsigned char* ws;
    __device__ __forceinline__ void mid(f32x4 (&)[2][2][4][2], const Unit&, int, int, int, int) const {}
    __device__ __forceinline__ void operator()(const f32x4 (&acc)[2][2][4][2], const Unit& u, int wr, int wc, int fr, int fq) const {
        float rsv[2][4];
#pragma unroll
        for (int ai = 0; ai < 2; ++ai)
#pragma unroll
            for (int m = 0; m < 4; ++m) rsv[ai][m] = ((const float*)(ws + W_RS1))[(size_t)u.pm * 256 + ai * 128 + wr * 64 + m * 16 + fr];
        __builtin_amdgcn_sched_barrier(0);
#pragma unroll
        for (int ai = 0; ai < 2; ++ai)
#pragma unroll
            for (int m = 0; m < 4; ++m) { const size_t row = (size_t)u.pm * 256 + ai * 128 + wr * 64 + m * 16 + fr;
                const float rs = rsqrtf(rsv[ai][m] * (1.0f / 1024.0f) + 1e-6f);
                u32x2 pk[2];
#pragma unroll
                for (int n = 0; n < 2; ++n) { f32x4 a;
#pragma unroll
                    for (int j = 0; j < 4; ++j) { const float gt = acc[ai][0][m][n][j] * rs, up = acc[ai][1][m][n][j] * rs; a[j] = gt * sigmoidf_(gt) * up; }
                    pk[n] = pack4(a); }
                *(u32x4*)((bf16_t*)(ws + W_ACT) + row * 2816 + u.pn * 128 + wc * 32 + col8_of(fq)) = widen16(pk[0], pk[1]); }
    }
};
struct EpiG6 {
    static constexpr bool AFTER_DRAIN = false, HAS_MID = false; static constexpr int MID_T = 0;
    unsigned char* ws;
    __device__ __forceinline__ void mid(f32x4 (&)[2][2][4][2], const Unit&, int, int, int, int) const {}
    __device__ __forceinline__ void operator()(const f32x4 (&acc)[2][2][4][2], const Unit& u, int wr, int wc, int fr, int fq) const {
#pragma unroll
        for (int ai = 0; ai < 2; ++ai) {
            u32x2 xv[4][2][2];
#pragma unroll
            for (int m = 0; m < 4; ++m) { const size_t row = (size_t)u.pm * 256 + ai * 128 + wr * 64 + m * 16 + fr;
#pragma unroll
                for (int bj = 0; bj < 2; ++bj)
#pragma unroll
                    for (int n = 0; n < 2; ++n) xv[m][bj][n] = *(const u32x2*)((const bf16_t*)(ws + W_X2) + row * 1024 + u.pn * 256 + bj * 128 + wc * 32 + n * 16 + fq * 4); }
            __builtin_amdgcn_sched_barrier(0);
#pragma unroll
            for (int m = 0; m < 4; ++m) { const size_t row = (size_t)u.pm * 256 + ai * 128 + wr * 64 + m * 16 + fr; float ss = 0.f;
#pragma unroll
                for (int bj = 0; bj < 2; ++bj) { u32x2 pk[2];
#pragma unroll
                    for (int n = 0; n < 2; ++n) { const u32x2 xg = xv[m][bj][n];
                        const f32x4 x3 = (f32x4){bf_lo(xg.x), bf_hi(xg.x), bf_lo(xg.y), bf_hi(xg.y)} + acc[ai][bj][m][n];
                        ss += x3[0] * x3[0] + x3[1] * x3[1] + x3[2] * x3[2] + x3[3] * x3[3];
                        pk[n] = pack4(x3); }
                    *(u32x4*)((bf16_t*)(ws + W_X3) + row * 1024 + u.pn * 256 + bj * 128 + wc * 32 + col8_of(fq)) = widen16(pk[0], pk[1]); }
                ss += __shfl_xor(ss, 16); ss += __shfl_xor(ss, 32);
                if (fq == 0) atomicAdd((float*)(ws + W_RS2) + row, ss); }
            __builtin_amdgcn_sched_barrier(0);
        }
    }
};
constexpr int ST_PITCH = 264, ST_MAT = 64 * ST_PITCH * 2, ST_BUF = 2 * ST_MAT;
template <int KIND> __device__ __forceinline__ void small_tile(CParams& p, LAS unsigned char* lds, int tile) {
    unsigned char* ws = p.ws;
    const int tid = opaque_tid(), w = tid >> 6, lane = tid & 63, fr = lane & 15, fq = lane >> 4;
    const int rt = tile >> 4, ct = tile & 15;
    const int row = NPT + rt * 64 + 16 * (w >> 1) + fr, ncol0 = ct * 64 + 32 * (w & 1);
    const int K = KIND == 2 ? 2816 : 1024;
    const bf16_t* Ag = (const bf16_t*)(ws + (KIND == 0 ? W_YCAT : (KIND == 1 ? W_MERGED : W_ACT))) + (size_t)(NPT + rt * 64) * K;
    const bf16_t* Bg = (const bf16_t*)(ws + (KIND == 0 ? W_BTM : (KIND == 1 ? W_BTO : W_BTD))) + (size_t)(ct * 64) * K;
    f32x4 acc[2] = {(f32x4){0.f, 0.f, 0.f, 0.f}, (f32x4){0.f, 0.f, 0.f, 0.f}};
    u32x4 ra[4], rb[4];
    auto gld = [&](int kc) {
#pragma unroll
        for (int q = 0; q < 4; ++q) { const int idx = tid + 512 * q, r2 = idx >> 5, c = idx & 31;
            ra[q] = *(const u32x4*)(Ag + (size_t)r2 * K + kc + c * 8); rb[q] = *(const u32x4*)(Bg + (size_t)r2 * K + kc + c * 8); }
    };
    auto lst = [&](int bi) {
#pragma unroll
        for (int q = 0; q < 4; ++q) { const int idx = tid + 512 * q, r2 = idx >> 5, c = idx & 31;
            *(LAS u32x4*)(lds + bi * ST_BUF + (r2 * ST_PITCH + c * 8) * 2) = ra[q]; *(LAS u32x4*)(lds + bi * ST_BUF + ST_MAT + (r2 * ST_PITCH + c * 8) * 2) = rb[q]; }
    };
    const int nchunk = K / 256;
    const bf16_t* gp = (const bf16_t*)(ws + W_GATES) + (size_t)row * 2048;
    __syncthreads();
    gld(0);
    for (int ci = 0; ci < nchunk; ++ci) {
        lst(ci & 1);
        __syncthreads();
        if (ci + 1 < nchunk) gld((ci + 1) * 256);
        if (KIND == 0 && ci == 2) {
#pragma unroll
            for (int u = 0; u < 2; ++u) acc[u] = acc[u] * ld_bf4(gp + ncol0 + 16 * u + 4 * fq);
        }
        LAS const bf16_t* Al = (LAS const bf16_t*)(lds + (ci & 1) * ST_BUF) + (16 * (w >> 1) + fr) * ST_PITCH + 8 * fq;
        LAS const bf16_t* Bl = (LAS const bf16_t*)(lds + (ci & 1) * ST_BUF + ST_MAT) + (32 * (w & 1) + fr) * ST_PITCH + 8 * fq;
#pragma unroll
        for (int s = 0; s < 8; ++s) {
            const bf16x8 a = *(const LAS bf16x8*)(Al + 32 * s), w0 = *(const LAS bf16x8*)(Bl + 32 * s), w1 = *(const LAS bf16x8*)(Bl + 16 * ST_PITCH + 32 * s);
            acc[0] = mfma16(w0, a, acc[0]); acc[1] = mfma16(w1, a, acc[1]);
        }
    }
    if (KIND == 0) {
#pragma unroll
        for (int u = 0; u < 2; ++u) { const int col = ncol0 + 16 * u + 4 * fq; *(u32x2*)((bf16_t*)(ws + W_MERGED) + (size_t)row * 1024 + col) = pack4(acc[u] * ld_bf4(gp + 1024 + col)); }
    } else if (KIND == 1) {
        const float* xr = p.in[1] + (size_t)(row - NPT) * 1024; float ss = 0.f;
#pragma unroll
        for (int u = 0; u < 2; ++u) { const int col = ncol0 + 16 * u + 4 * fq;
            const f32x4 x2 = *(const f32x4*)(xr + col) + acc[u];
            ss += x2[0] * x2[0] + x2[1] * x2[1] + x2[2] * x2[2] + x2[3] * x2[3];
            *(u32x2*)((bf16_t*)(ws + W_X2) + (size_t)row * 1024 + col) = pack4(x2); }
        ss += __shfl_xor(ss, 16); ss += __shfl_xor(ss, 32);
        if (fq == 0) atomicAdd((float*)(ws + W_RS1) + row, ss);
    } else {
        float ss = 0.f;
#pragma unroll
        for (int u = 0; u < 2; ++u) { const int col = ncol0 + 16 * u + 4 * fq;
            const f32x4 x3 = ld_bf4((const bf16_t*)(ws + W_X2) + (size_t)row * 1024 + col) + acc[u];
            ss += x3[0] * x3[0] + x3[1] * x3[1] + x3[2] * x3[2] + x3[3] * x3[3];
            *(u32x2*)((bf16_t*)(ws + W_X3) + (size_t)row * 1024 + col) = pack4(x3); }
        ss += __shfl_xor(ss, 16); ss += __shfl_xor(ss, 32);
        if (fq == 0) atomicAdd((float*)(ws + W_RS2) + row, ss);
    }
}
__device__ __forceinline__ void phase_gn(int bid, int nb) {
    CParams& p = kparams();
    unsigned char* ws = p.ws;
    const int tid4 = opaque_tid(); const int lane = tid4 & 63; const int gw = bid * 8 + (tid4 >> 6), nw = nb * 8;
    const int c0 = lane * 8, hd = lane >> 3;
    const f32x4 lw0 = *(const f32x4*)(p.in[19] + c0), lw1 = *(const f32x4*)(p.in[19] + c0 + 4), lb0 = *(const f32x4*)(p.in[20] + c0), lb1 = *(const f32x4*)(p.in[20] + c0 + 4);
#pragma unroll 1
    for (int m0 = gw; m0 < NTOK; m0 += 4 * nw) {
      f32x4 ya[4], yb[4]; u32x4 vr[4], gr[4]; float bn[4];
#pragma unroll
      for (int q = 0; q < 4; ++q) { const int mm = min(m0 + q * nw, NTOK - 1);
          const float* y = (const float*)(ws + W_YRAW) + (size_t)mm * 512 + c0; ya[q] = *(const f32x4*)y; yb[q] = *(const f32x4*)(y + 4);
          bn[q] = ((const float*)(ws + W_BON))[(size_t)mm * 8 + hd];
          vr[q] = *(const u32x4*)((const bf16_t*)(ws + W_V) + (size_t)mm * 512 + c0); gr[q] = *(const u32x4*)((const bf16_t*)(ws + W_G) + (size_t)mm * 512 + c0); }
#pragma unroll
      for (int q = 0; q < 4; ++q) { const int m = m0 + q * nw; if (m < NTOK) {
        const f32x4 y0 = ya[q], y1 = yb[q];
        const float mean = allreduce8((y0[0] + y0[1]) + (y0[2] + y0[3]) + (y1[0] + y1[1]) + (y1[2] + y1[3])) * (1.0f / 64.0f);
        const f32x4 e0 = y0 - mean, e1 = y1 - mean;
        const float var = allreduce8((e0[0] * e0[0] + e0[1] * e0[1]) + (e0[2] * e0[2] + e0[3] * e0[3]) + (e1[0] * e1[0] + e1[1] * e1[1]) + (e1[2] * e1[2] + e1[3] * e1[3])) * (1.0f / 64.0f);
        const float rstd = rsqrtf(var + 64e-5f);
        const float bon = bn[q]; const u32x4 vq = vr[q], gq = gr[q];
        const f32x4 v0 = (f32x4){bf_lo(vq.x), bf_hi(vq.x), bf_lo(vq.y), bf_hi(vq.y)}, v1 = (f32x4){bf_lo(vq.z), bf_hi(vq.z), bf_lo(vq.w), bf_hi(vq.w)};
        const f32x4 g0 = (f32x4){bf_lo(gq.x), bf_hi(gq.x), bf_lo(gq.y), bf_hi(gq.y)}, g1 = (f32x4){bf_lo(gq.z), bf_hi(gq.z), bf_lo(gq.w), bf_hi(gq.w)};
        const f32x4 o0 = (e0 * rstd * lw0 + lb0 + v0 * bon) * g0, o1 = (e1 * rstd * lw1 + lb1 + v1 * bon) * g1;
        u32x4 w; w.x = cvt_pk_bf16(o0[0], o0[1]); w.y = cvt_pk_bf16(o0[2], o0[3]); w.z = cvt_pk_bf16(o1[0], o1[1]); w.w = cvt_pk_bf16(o1[2], o1[3]);
        *(u32x4*)((bf16_t*)(ws + W_YCAT) + (size_t)m * 1024 + c0) = w;
      } }
    }
}
__device__ __forceinline__ void phase4(LAS unsigned char* lds, int bid, int nb) {
    CParams& p = kparams();
    pg8::Gemm g{(const bf16_t*)(p.ws + W_YCAT), (const bf16_t*)(p.ws + W_BTM), NPT, 1024, 1024};
    pg8::StaticOrder S; S.init(NPT, 1024, nb, bid); EpiG3 E{p.ws}; pg8::gemm_phase(lds, g, S, E);
    for (int tile = bid; tile < 256; tile += nb) small_tile<0>(p, lds, tile);
}
__device__ __forceinline__ void phase5(LAS unsigned char* lds, int bid, int nb) {
    CParams& p = kparams();
    pg8::Gemm g{(const bf16_t*)(p.ws + W_MERGED), (const bf16_t*)(p.ws + W_BTO), NPT, 1024, 1024};
    pg8::StaticOrder S; S.init(NPT, 1024, nb, bid); EpiG4 E{p.ws, p.in[0], p.in[1]}; pg8::gemm_phase(lds, g, S, E);
    for (int tile = bid; tile < 256; tile += nb) small_tile<1>(p, lds, tile);
}
__device__ __forceinline__ void phase6(LAS unsigned char* lds, int bid, int nb) {
    CParams& p = kparams();
    pg8::Gemm g{(const bf16_t*)(p.ws + W_X2), (const bf16_t*)(p.ws + W_BTGU), NTOK, 5632, 1024};
    pg8::StaticOrder S; S.init(NTOK, 5632, nb, bid); EpiG5 E{p.ws}; pg8::gemm_phase(lds, g, S, E);
}
__device__ __forceinline__ void phase7(LAS unsigned char* lds, int bid, int nb) {
    CParams& p = kparams();
    pg8::Gemm g{(const bf16_t*)(p.ws + W_ACT), (const bf16_t*)(p.ws + W_BTD), NPT, 1024, 2816};
    pg8::StaticOrder S; S.init(NPT, 1024, nb, bid); EpiG6 E{p.ws}; pg8::gemm_phase(lds, g, S, E);
    for (int tile = bid; tile < 256; tile += nb) small_tile<2>(p, lds, tile);
}
__device__ __forceinline__ void phase8(int bid, int nb) {
    CParams& p = kparams();
    const size_t gtid = (size_t)bid * NTHR + opaque_tid(), gsz = (size_t)nb * NTHR;
    const bf16_t* x3 = (const bf16_t*)(p.ws + W_X3); const float* rs2 = (const float*)(p.ws + W_RS2); const float* gf = p.in[31];
    const int c8 = (int)(gtid & 127) * 8; const f32x4 g0 = *(const f32x4*)(gf + c8), g1 = *(const f32x4*)(gf + c8 + 4);
    const unsigned total = (unsigned)NTOK * 128u, st = (unsigned)gsz;
#pragma unroll 1
    for (unsigned i0 = (unsigned)gtid; i0 < total; i0 += 4u * st) {
        u32x4 xr[4]; float rr[4];
#pragma unroll
        for (int q = 0; q < 4; ++q) { const unsigned ii = min(i0 + (unsigned)q * st, total - 128u + (unsigned)(gtid & 127)); const unsigned row = ii >> 7; rr[q] = rs2[row]; xr[q] = *(const u32x4*)(x3 + (size_t)row * 1024 + c8); }
#pragma unroll
        for (int q = 0; q < 4; ++q) { const unsigned i = i0 + (unsigned)q * st; if (i < total) { const size_t row = i >> 7;
            const float rs = rsqrtf(rr[q] * (1.0f / 1024.0f) + 1e-6f); const u32x4 x = xr[q];
            *(f32x4*)(p.out + row * 1024 + c8) = (f32x4){bf_lo(x.x), bf_hi(x.x), bf_lo(x.y), bf_hi(x.y)} * rs * g0;
            *(f32x4*)(p.out + row * 1024 + c8 + 4) = (f32x4){bf_lo(x.z), bf_hi(x.z), bf_lo(x.w), bf_hi(x.w)} * rs * g1; } }
    }
}

#define XB_TMO      128
#define XB_XCNT(j)  (256  + 64 * (j))
#define XB_XSUB(j)  (1280 + 64 * (j))
#define XB_XGEN(j)  (2304 + 64 * (j))
#define XB_TOP      3328
#define XB_TOPGEN   3392
#define XB_SPIN_CAP (1u << 22)
__device__ __forceinline__ unsigned xb_ld(unsigned* p)              { return __hip_atomic_load(p, __ATOMIC_RELAXED, __HIP_MEMORY_SCOPE_AGENT); }
__device__ __forceinline__ unsigned xb_add(unsigned* p, unsigned v) { return __hip_atomic_fetch_add(p, v, __ATOMIC_RELAXED, __HIP_MEMORY_SCOPE_AGENT); }
__device__ __forceinline__ unsigned xb_xcc_id() { return (unsigned)__builtin_amdgcn_s_getreg((3 << 11) | 20) & 0xFu; }
#define XB_SPIN(cond, bar) do { unsigned _sp = 0; while (cond) { __builtin_amdgcn_s_sleep(1); \
    if ((++_sp & 255u) == 0u) { if (xb_ld(&(bar)[XB_TMO])) break; if (_sp > XB_SPIN_CAP) { atomicAdd(&(bar)[XB_TMO], 1u); break; } } } } while (0)
struct XcdBarrier { unsigned* bar; unsigned x; volatile LAS unsigned* st; };
__device__ __forceinline__ XcdBarrier xcd_barrier_post(unsigned* bar, volatile LAS unsigned* st) {
    XcdBarrier b; b.bar = bar; b.x = xb_xcc_id(); b.st = st;
    if (threadIdx.x == 0) (void)xb_add(&bar[XB_XCNT(b.x)], 1u);
    return b;
}
__device__ __forceinline__ void xcd_barrier_complete(unsigned* bar, unsigned x, unsigned& nloc, unsigned& nx) {
    const unsigned G = gridDim.x * gridDim.y * gridDim.z;
    unsigned sum, cnt, mine, sp = 0u;
    for (;;) {
        sum = 0u; cnt = 0u; mine = 0u;
#pragma unroll
        for (unsigned j = 0; j < 16; ++j) { const unsigned c = xb_ld(&bar[XB_XCNT(j)]); sum += c; cnt += (c > 0u) ? 1u : 0u; mine = (j == x) ? c : mine; }
        if (sum == G) break;
        __builtin_amdgcn_s_sleep(1);
        if ((++sp & 255u) == 0u) { if (xb_ld(&bar[XB_TMO])) break; if (sp > XB_SPIN_CAP) { atomicAdd(&bar[XB_TMO], 1u); break; } }
    }
    nloc = mine > 0u ? mine : 1u; nx = cnt > 0u ? cnt : 1u;
}
__device__ __forceinline__ void xcd_barrier(const XcdBarrier& b) {
    asm volatile("s_waitcnt vmcnt(0)" ::: "memory");
    __syncthreads();
    if (threadIdx.x == 0) {
        unsigned* bar = b.bar;
        __builtin_amdgcn_s_waitcnt(0);
        unsigned nloc = b.st[0], nx = b.st[1];
        if (nloc == 0u) { xcd_barrier_complete(bar, b.x, nloc, nx); b.st[0] = nloc; b.st[1] = nx; }
        const unsigned old = xb_add(&bar[XB_XSUB(b.x)], 1u);
        const unsigned gen = old / nloc;
        if (old + 1u == (gen + 1u) * nloc) {
            __builtin_amdgcn_fence(__ATOMIC_RELEASE, "agent");
            asm volatile("s_waitcnt vmcnt(0)" ::: "memory");
            const unsigned og = xb_add(&bar[XB_TOP], 1u);
            const unsigned tg = og / nx;
            if (og + 1u == (tg + 1u) * nx) xb_add(&bar[XB_TOPGEN], 1u);
            else XB_SPIN(xb_ld(&bar[XB_TOPGEN]) == tg, bar);
            __builtin_amdgcn_fence(__ATOMIC_ACQUIRE, "agent");
            xb_add(&bar[XB_XGEN(b.x)], 1u);
            asm volatile("s_waitcnt vmcnt(0)" ::: "memory");
        } else {
            XB_SPIN(xb_ld(&bar[XB_XGEN(b.x)]) == gen, bar);
            __builtin_amdgcn_fence(__ATOMIC_ACQUIRE, "agent");
            asm volatile("s_waitcnt vmcnt(0)" ::: "memory");
        }
    }
    __syncthreads();
}

extern __shared__ __attribute__((aligned(16))) unsigned char smem_raw[];

__global__ __launch_bounds__(512) void fwd_kernel(Params p) {
    cg::grid_group grid = cg::this_grid();
    LAS unsigned char* lds = (LAS unsigned char*)smem_raw;
    const int bid = blockIdx.x, nb = gridDim.x;
    if (p.ph_lo < 0) grid.sync();
    volatile LAS unsigned* bst = (volatile LAS unsigned*)(lds + LDS_BYTES - 32);
    if (threadIdx.x == 0) { bst[0] = 0u; bst[1] = 0u; }
    __syncthreads();
    const XcdBarrier xb = xcd_barrier_post((unsigned*)(p.ws + W_BAR), bst);
#define RUN_PHASE(k, call) { if ((k) > 0) xcd_barrier(xb); call; }
    RUN_PHASE(0, phase0(bid, nb));
    RUN_PHASE(1, phase1(lds, bid, nb));
    RUN_PHASE(2, phase2(lds, bid, nb));
    RUN_PHASE(3, phase3(lds, bid, nb));
    RUN_PHASE(4, phase_gn(bid, nb));
    RUN_PHASE(5, phase4(lds, bid, nb));
    RUN_PHASE(6, phase5(lds, bid, nb));
    RUN_PHASE(7, phase6(lds, bid, nb));
    RUN_PHASE(8, phase7(lds, bid, nb));
    RUN_PHASE(9, phase8(bid, nb));
#undef RUN_PHASE
}

extern "C" void kernel_launch(void* const* d_in, const int* in_sizes, int n_in, void* d_out, int out_size, void* d_ws, size_t ws_size, hipStream_t stream) {
    static int grid_blocks = 0;
    if (!grid_blocks) {
        int dev = 0, cus = 0, per_cu = 0;
        (void)hipGetDevice(&dev);
        (void)hipDeviceGetAttribute(&cus, hipDeviceAttributeMultiprocessorCount, dev);
        (void)hipFuncSetAttribute((const void*)fwd_kernel, hipFuncAttributeMaxDynamicSharedMemorySize, LDS_BYTES);
        (void)hipOccupancyMaxActiveBlocksPerMultiprocessor(&per_cu, (const void*)fwd_kernel, NTHR, LDS_BYTES);
        if (per_cu != 1) fprintf(stderr, "note: occupancy query reports %d blocks per CU (expected 1)\n", per_cu);
        grid_blocks = cus;
        if (ws_size < W_END) fprintf(stderr, "workspace too small: %zu < %zu\n", ws_size, (size_t)W_END);
    }
    (void)hipMemsetAsync((unsigned char*)d_ws + W_BAR, 0, W_BAR_BYTES, stream);
    Params p{};
    for (int i = 0; i < 32; ++i) p.in[i] = (const float*)d_in[i];
    p.out = (float*)d_out; p.ws = (unsigned char*)d_ws; p.ph_lo = 0; p.ph_hi = 10;
    void* args[] = {&p};
    hipError_t e = hipLaunchCooperativeKernel((const void*)fwd_kernel, dim3(grid_blocks), dim3(NTHR), args, LDS_BYTES, stream);
    if (e != hipSuccess) fprintf(stderr, "cooperative launch failed: %s (grid %d)\n", hipGetErrorString(e), grid_blocks);
}
```

```cpp
#include <hip/hip_runtime.h>
#include <hip/hip_cooperative_groups.h>
#include <cstdio>
#include <cstdint>
namespace cg = cooperative_groups;

#define LAS __attribute__((address_space(3)))
typedef unsigned short bf16_t;
typedef short bf16x8 __attribute__((ext_vector_type(8)));
typedef short bf16x4 __attribute__((ext_vector_type(4)));
typedef float f32x2 __attribute__((ext_vector_type(2)));
typedef float f32x4 __attribute__((ext_vector_type(4)));
typedef float f32x8 __attribute__((ext_vector_type(8)));
typedef float f32x16 __attribute__((ext_vector_type(16)));
typedef unsigned u32x2 __attribute__((ext_vector_type(2)));
typedef unsigned u32x4 __attribute__((ext_vector_type(4)));

constexpr int NTOK = 17408, NPT = 16384, TP = 4096;
constexpr int LDS_BYTES = 147456;
constexpr int NTHR = 512;

constexpr size_t O_YP = 0;
constexpr size_t O_YS = O_YP + 16777216;
constexpr size_t O_PCMP = O_YS + 1048576;
constexpr size_t O_PSLC = O_PCMP + 4194304;
constexpr size_t O_PWIN = O_PSLC + 4194304;
constexpr size_t O_PRWKV = O_PWIN + 524288;
constexpr size_t O_PSHIFT = O_PRWKV + 131072;
constexpr size_t O_SCMP = O_PSHIFT + 7296;
constexpr size_t O_SSLC = O_SCMP + 262144;
constexpr size_t O_SWIN = O_SSLC + 262144;
constexpr size_t O_SRWKV = O_SWIN + 16777216;
constexpr size_t O_SSHIFT = O_SRWKV + 4194304;

constexpr size_t AL(size_t x) { return (x + 255) & ~(size_t)255; }
constexpr size_t W_BT1 = 0;
constexpr size_t W_BTM = W_BT1 + AL(5376ull * 1024 * 2);
constexpr size_t W_BTO = W_BTM + AL(1024ull * 1024 * 2);
constexpr size_t W_BTGU = W_BTO + AL(1024ull * 1024 * 2);
constexpr size_t W_BTD = W_BTGU + AL(5632ull * 1024 * 2);
constexpr size_t W_BTC1 = W_BTD + AL(1024ull * 2816 * 2);
constexpr size_t W_BTC2 = W_BTC1 + AL(2ull * 256 * 1024 * 2);
constexpr size_t W_BIASC = W_BTC2 + AL(2ull * 64 * 128 * 2);
constexpr size_t W_BTDEC = W_BIASC + AL(2 * 256 * 4);
constexpr size_t W_BTAAA = W_BTDEC + AL(512 * 64 * 2);
constexpr size_t W_BTGATE = W_BTAAA + AL(512 * 64 * 2);
constexpr size_t W_ROPE = W_BTGATE + AL(512 * 160 * 2);
constexpr size_t W_H = W_ROPE + AL(4096 * 16 * 4);
constexpr size_t W_P = W_H + AL((size_t)NTOK * 1024 * 2);
constexpr size_t W_QC = W_P + AL((size_t)NTOK * 1824 * 2);
constexpr size_t W_QR = W_QC + AL((size_t)NTOK * 512 * 2);
constexpr size_t W_CPM = W_QR + AL((size_t)NTOK * 512 * 2);
constexpr size_t W_CSM = W_CPM + AL(2ull * 2048 * 1024 * 2);
constexpr size_t W_KS = W_CSM + AL(2ull * 32768 * 1024 * 2);
constexpr size_t W_VST = W_KS + AL(8ull * 4096 * 64 * 2);
constexpr size_t W_KW = W_VST + AL(8ull * 4096 * 64 * 2);
constexpr size_t W_VWT = W_KW + AL(8ull * 4096 * 64 * 2);
constexpr size_t W_KCP = W_VWT + AL(8ull * 4096 * 64 * 2);
constexpr size_t W_VCPT = W_KCP + AL(8ull * 256 * 64 * 2);
constexpr size_t W_KCS = W_VCPT + AL(8ull * 256 * 64 * 2);
constexpr size_t W_VCST = W_KCS + AL(256ull * 128 * 64 * 2);
constexpr size_t W_GATES = W_VCST + AL(256ull * 128 * 64 * 2);
constexpr size_t W_GN = W_GATES + AL((size_t)NTOK * 2048 * 2);
constexpr size_t W_R = W_GN + AL((size_t)NTOK * 24 * 4);
constexpr size_t RW_SZ = AL((size_t)NTOK * 512 * 4);
constexpr size_t W_DEC = W_R + RW_SZ;
constexpr size_t W_KH = W_DEC + RW_SZ;
constexpr size_t W_V = W_KH + RW_SZ;
constexpr size_t W_AV = W_V + RW_SZ;
constexpr size_t W_BV = W_AV + RW_SZ;
constexpr size_t W_G = W_BV + RW_SZ;
constexpr size_t W_YCAT = W_G + RW_SZ;
constexpr size_t W_MERGED = W_YCAT + AL((size_t)NTOK * 1024 * 2);
constexpr size_t W_X2 = W_MERGED + AL((size_t)NTOK * 1024 * 2);
constexpr size_t W_A2 = W_X2 + AL((size_t)NTOK * 1024 * 4);
constexpr size_t W_ACT = W_A2 + AL((size_t)NTOK * 1024 * 2);
constexpr size_t W_X3 = W_ACT + AL((size_t)NTOK * 2816 * 2);
constexpr size_t W_RS1 = W_X3 + AL((size_t)NTOK * 1024 * 4);
constexpr size_t W_RS2 = W_RS1 + AL((size_t)NTOK * 4);
constexpr size_t W_CTR = W_RS2 + AL((size_t)NTOK * 4);
constexpr size_t W_YRAW = W_CTR + 256;
constexpr size_t W_BON = W_YRAW + RW_SZ;
constexpr size_t W_COP = W_BON + AL((size_t)NTOK * 8 * 4);
constexpr size_t W_BAR = W_COP + 32ull * 256 * 18432;
constexpr size_t W_BAR_BYTES = 3456 * 4 + 256;
constexpr size_t W_END = W_BAR + AL(W_BAR_BYTES);

struct Params { const float* in[32]; float* out; unsigned char* ws; int ph_lo, ph_hi; };

typedef const __attribute__((address_space(4))) Params CParams;
__device__ __forceinline__ CParams& kparams() {
    CParams* kp = (CParams*)__builtin_amdgcn_kernarg_segment_ptr();
    asm volatile("" : "+s"(kp));
    return *kp;
}
__device__ __forceinline__ int opaque_tid() { int t = threadIdx.x; asm volatile("" : "+v"(t)); return t; }
typedef _Float16 h16x2 __attribute__((ext_vector_type(2)));
typedef _Float16 h16x8 __attribute__((ext_vector_type(8)));
__device__ __forceinline__ unsigned cvt_pk_bf16(float lo, float hi) { h16x2 v; v[0] = (_Float16)lo; v[1] = (_Float16)hi; return __builtin_bit_cast(unsigned, v); }
__device__ __forceinline__ float bf_lo(unsigned u) { const h16x2 v = __builtin_bit_cast(h16x2, u); return (float)v[0]; }
__device__ __forceinline__ float bf_hi(unsigned u) { const h16x2 v = __builtin_bit_cast(h16x2, u); return (float)v[1]; }
__device__ __forceinline__ float bf2f(bf16_t b) { return (float)__builtin_bit_cast(_Float16, b); }
__device__ __forceinline__ bf16_t f2bf(float f) { return __builtin_bit_cast(bf16_t, (_Float16)f); }
__device__ __forceinline__ u32x2 pack4(f32x4 v) { u32x2 r; r.x = cvt_pk_bf16(v[0], v[1]); r.y = cvt_pk_bf16(v[2], v[3]); return r; }
__device__ __forceinline__ u32x4 widen16(u32x2 a, u32x2 b) {
    const auto r0 = __builtin_amdgcn_permlane16_swap(a.x, b.x, false, false);
    const auto r1 = __builtin_amdgcn_permlane16_swap(a.y, b.y, false, false);
    return (u32x4){r0[0], r1[0], r0[1], r1[1]};
}
__device__ __forceinline__ int col8_of(int fq) { return ((fq & 1) << 4) | ((fq >> 1) << 3); }
__device__ __forceinline__ bf16x8 pack8(float a0, float a1, float a2, float a3, float a4, float a5, float a6, float a7) {
    u32x4 r; r.x = cvt_pk_bf16(a0, a1); r.y = cvt_pk_bf16(a2, a3); r.z = cvt_pk_bf16(a4, a5); r.w = cvt_pk_bf16(a6, a7);
    return __builtin_bit_cast(bf16x8, r);
}
__device__ __forceinline__ f32x8 ld_bf8(const bf16_t* p) {
    const u32x4 v = *(const u32x4*)p; f32x8 o;
    o[0] = bf_lo(v.x); o[1] = bf_hi(v.x); o[2] = bf_lo(v.y); o[3] = bf_hi(v.y); o[4] = bf_lo(v.z); o[5] = bf_hi(v.z); o[6] = bf_lo(v.w); o[7] = bf_hi(v.w); return o;
}
__device__ __forceinline__ f32x4 ld_bf4(const bf16_t* p) {
    const u32x2 v = *(const u32x2*)p; f32x4 o; o[0] = bf_lo(v.x); o[1] = bf_hi(v.x); o[2] = bf_lo(v.y); o[3] = bf_hi(v.y); return o;
}
__device__ __forceinline__ float sigmoidf_(float x) { return __builtin_amdgcn_rcpf(1.0f + __expf(-x)); }
__device__ __forceinline__ float tanhf_(float x) { return 1.0f - 2.0f * __builtin_amdgcn_rcpf(__expf(2.0f * x) + 1.0f); }
__device__ __forceinline__ float dppf(float x, const int ctrl_sel) {
    const int xi = __float_as_int(x); int r;
    if (ctrl_sel == 0) r = __builtin_amdgcn_update_dpp(0, xi, 0xB1, 0xF, 0xF, false);
    else if (ctrl_sel == 1) r = __builtin_amdgcn_update_dpp(0, xi, 0x4E, 0xF, 0xF, false);
    else r = __builtin_amdgcn_update_dpp(0, xi, 0x141, 0xF, 0xF, false);
    return __int_as_float(r);
}
__device__ __forceinline__ float allreduce4(float x) { x += dppf(x, 0); x += dppf(x, 1); return x; }
__device__ __forceinline__ float allreduce8(float x) { x += dppf(x, 0); x += dppf(x, 1); x += dppf(x, 2); return x; }
__device__ __forceinline__ f32x4 mfma16(bf16x8 a, bf16x8 b, f32x4 c) { return __builtin_amdgcn_mfma_f32_16x16x32_f16(__builtin_bit_cast(h16x8, a), __builtin_bit_cast(h16x8, b), c, 0, 0, 0); }
__device__ __forceinline__ f32x16 mfma32(bf16x8 a, bf16x8 b, f32x16 c) { return __builtin_amdgcn_mfma_f32_32x32x16_f16(__builtin_bit_cast(h16x8, a), __builtin_bit_cast(h16x8, b), c, 0, 0, 0); }

namespace pg8 {
constexpr int BM = 256, BK = 64, HALF = 128, HTB = HALF * BK * 2, STAGE_BYTES = 8 * HTB, NXCD = 8, WGM = 8;
__host__ __device__ __forceinline__ int lds_byte(int r, int c) { const int st = (r >> 4) * 2 + (c >> 5), rr = r & 15, cc = c & 31, ob = rr * 64 + cc * 2; return st * 1024 + (ob ^ (((ob >> 9) & 1) << 5)); }
__host__ __device__ __forceinline__ void stage_rc(int b, int& R, int& C) { const int st = b / 1024, sb = b % 1024, swz = sb ^ (((sb >> 9) & 1) << 5); R = (st >> 1) * 16 + swz / 64; C = (st & 1) * 32 + (swz % 64) / 2; }
struct Unit { int pm, pn; };
struct Gemm { const bf16_t* A; const bf16_t* Bt; int M, N, K; };
struct StaticOrder {
    int nM, nN, nwg, G, c, i0, i1;
    __device__ void init(int M, int N, int G_, int c_) { nM = M / BM; nN = N / BM; nwg = nM * nN; G = G_; c = c_; i0 = 0; i1 = 1 << 30; }
    __device__ bool next(int i_, Unit& u) const {
        const int i = i_ + i0; if (i >= i1) return false;
        const long L = (long)i * G + c; if (L >= nwg) return false;
        int wgid = (int)L; { const int q = nwg / NXCD, r = nwg % NXCD, xcd = wgid % NXCD, off = wgid / NXCD; wgid = (xcd < r ? xcd * (q + 1) : r * (q + 1) + (xcd - r) * q) + off; }
        const int nig = WGM * nN, gid = wgid / nig, fm = gid * WGM, gsz = (nM - fm) < WGM ? (nM - fm) : WGM;
        u.pm = fm + ((wgid % nig) % gsz); u.pn = (wgid % nig) / gsz; return true;
    }
};
struct OneUnit { Unit u; __device__ bool next(int i, Unit& o) const { if (i != 0) return false; o = u; return true; } };

template <class Epi, class Sched>
__device__ __forceinline__ void gemm_phase(LAS unsigned char* lds, const Gemm g, const Sched& S, const Epi& E) {
    const int tid = opaque_tid(), wid = __builtin_amdgcn_readfirstlane(tid >> 6), lane = tid & 63, wr = wid >> 2, wc = wid & 3, fr = lane & 15, fq = lane >> 4;
    const int K = g.K, nt = K / BK;
    unsigned voffA[2], voffB[2];
#pragma unroll
    for (int i = 0; i < 2; ++i) { int R, C; stage_rc(tid * 16 + i * 8192, R, C); voffA[i] = (unsigned)(R * K + C) * 2u; voffB[i] = voffA[i]; }
    const size_t kstep = (size_t)(BK * 2);
    const size_t hstep = (size_t)HALF * K * 2;
    const size_t tstep = 2 * hstep;
    const unsigned ldsw = (unsigned)wid * 1024u;
    const int aoff = lds_byte(wr * 64 + fr, fq * 8), boff = lds_byte(wc * 32 + fr, fq * 8);
#define PG8_SA(b, h) (((b) * 2 + (h)) * HTB)
#define PG8_SB(b, h) ((4 + (b) * 2 + (h)) * HTB)
#define PG8_STAGE(bufoff, gbase, voff) do { _Pragma("unroll") for (int _i = 0; _i < 2; ++_i) \
        __builtin_amdgcn_global_load_lds((const unsigned*)((const char*)(gbase) + (voff)[_i]), (LAS unsigned*)(lds + (bufoff) + ldsw + _i * 8192), 16, 0, 0); } while (0)
#define PG8_LDA(dst, b, h) do { _Pragma("unroll") for (int m = 0; m < 4; ++m) _Pragma("unroll") for (int k = 0; k < 2; ++k) dst[m][k] = *(const LAS bf16x8*)(lds + PG8_SA(b, h) + aoff + m * 2048 + k * 1024); } while (0)
#define PG8_LDB(dst, b, h) do { _Pragma("unroll") for (int n = 0; n < 2; ++n) _Pragma("unroll") for (int k = 0; k < 2; ++k) dst[n][k] = *(const LAS bf16x8*)(lds + PG8_SB(b, h) + boff + n * 2048 + k * 1024); } while (0)
#define PG8_MMA(ai, bj, At, Bt) do { __builtin_amdgcn_s_setprio(1); _Pragma("unroll") for (int m = 0; m < 4; ++m) _Pragma("unroll") for (int n = 0; n < 2; ++n) _Pragma("unroll") for (int k = 0; k < 2; ++k) \
        acc[ai][bj][m][n] = __builtin_amdgcn_mfma_f32_16x16x32_f16(__builtin_bit_cast(h16x8, Bt[n][k]), __builtin_bit_cast(h16x8, At[m][k]), acc[ai][bj][m][n], 0, 0, 0); __builtin_amdgcn_s_setprio(0); } while (0)
#define PG8_WAIT_V(n) asm volatile("s_waitcnt vmcnt(" #n ")" ::: "memory")
#define PG8_WAIT_L(n) asm volatile("s_waitcnt lgkmcnt(" #n ")" ::: "memory")
#define PG8_BAR __builtin_amdgcn_s_barrier()
#define PG8_SCHED __builtin_amdgcn_sched_barrier(0)
    Unit cur, nxt; int ui = 0;
    if (!S.next(0, cur)) return;
    f32x4 acc[2][2][4][2];
#pragma unroll
    for (int a = 0; a < 2; ++a)
#pragma unroll
        for (int b = 0; b < 2; ++b)
#pragma unroll
            for (int m = 0; m < 4; ++m)
#pragma unroll
                for (int n = 0; n < 2; ++n) acc[a][b][m][n] = (f32x4){0.f, 0.f, 0.f, 0.f};
    bf16x8 At[4][2], B0[2][2], B1[2][2];
    const char* cA = (const char*)g.A + (size_t)cur.pm * tstep; const char* cB = (const char*)g.Bt + (size_t)cur.pn * tstep;
    PG8_STAGE(PG8_SB(0, 0), cB, voffB); PG8_STAGE(PG8_SA(0, 0), cA, voffA); PG8_STAGE(PG8_SB(0, 1), cB + hstep, voffB); PG8_STAGE(PG8_SA(0, 1), cA + hstep, voffA);
    if (wr == 1) PG8_BAR;
    PG8_WAIT_V(4); PG8_BAR;
    PG8_STAGE(PG8_SB(1, 0), cB + kstep, voffB); PG8_STAGE(PG8_SA(1, 0), cA + kstep, voffA); PG8_STAGE(PG8_SB(1, 1), cB + hstep + kstep, voffB);
    PG8_WAIT_V(6); PG8_BAR;
    for (;;) {
        const bool has_next = S.next(ui + 1, nxt);
        const char* nA = has_next ? (const char*)g.A + (size_t)nxt.pm * tstep : cA; const char* nB = has_next ? (const char*)g.Bt + (size_t)nxt.pn * tstep : cB;
        for (int t = 0; t < nt; t += 2) {
            const bool last = (t == nt - 2);
            const char* a1 = cA + (size_t)(t + 1) * kstep;
            const char* a2 = last ? nA : cA + (size_t)(t + 2) * kstep; const char* b2 = last ? nB : cB + (size_t)(t + 2) * kstep;
            const char* a3 = a2 + kstep; const char* b3 = b2 + kstep;
            if constexpr (Epi::HAS_MID) { if (t == Epi::MID_T) E.mid(acc, cur, wr, wc, fr, fq); }
            PG8_LDB(B0, 0, 0); PG8_SCHED; PG8_LDA(At, 0, 0); PG8_STAGE(PG8_SA(1, 1), a1 + hstep, voffA);
            PG8_WAIT_L(8); PG8_BAR; PG8_WAIT_L(0); PG8_MMA(0, 0, At, B0); PG8_BAR; PG8_SCHED;
            PG8_LDB(B1, 0, 1); PG8_STAGE(PG8_SB(0, 0), b2, voffB);
            PG8_BAR; PG8_WAIT_L(0); PG8_MMA(0, 1, At, B1); PG8_BAR;
            PG8_LDA(At, 0, 1); PG8_STAGE(PG8_SA(0, 0), a2, voffA);
            PG8_BAR; PG8_WAIT_L(0); PG8_MMA(1, 0, At, B0); PG8_BAR; PG8_SCHED;
            PG8_STAGE(PG8_SB(0, 1), b2 + hstep, voffB);
            PG8_WAIT_V(6); PG8_BAR; PG8_MMA(1, 1, At, B1); PG8_BAR;
            PG8_LDB(B0, 1, 0); PG8_SCHED; PG8_LDA(At, 1, 0); PG8_STAGE(PG8_SA(0, 1), a2 + hstep, voffA);
            PG8_WAIT_L(8); PG8_BAR; PG8_WAIT_L(0); PG8_MMA(0, 0, At, B0); PG8_BAR; PG8_SCHED;
            PG8_LDB(B1, 1, 1); PG8_STAGE(PG8_SB(1, 0), b3, voffB);
            PG8_BAR; PG8_WAIT_L(0); PG8_MMA(0, 1, At, B1); PG8_BAR;
            PG8_LDA(At, 1, 1); PG8_STAGE(PG8_SA(1, 0), a3, voffA);
            PG8_BAR; PG8_WAIT_L(0); PG8_MMA(1, 0, At, B0); PG8_BAR; PG8_SCHED;
            PG8_STAGE(PG8_SB(1, 1), b3 + hstep, voffB);
            PG8_WAIT_V(6); PG8_BAR; PG8_MMA(1, 1, At, B1); PG8_BAR;
        }
        if constexpr (!Epi::AFTER_DRAIN) { E(acc, cur, wr, wc, fr, fq); }
        if (!has_next) break;
#pragma unroll
        for (int a = 0; a < 2; ++a)
#pragma unroll
            for (int b = 0; b < 2; ++b)
#pragma unroll
                for (int m = 0; m < 4; ++m)
#pragma unroll
                    for (int n = 0; n < 2; ++n) acc[a][b][m][n] = (f32x4){0.f, 0.f, 0.f, 0.f};
        cur = nxt; cA = nA; cB = nB; ++ui;
    }
    PG8_WAIT_V(0);
    if (wr == 0) PG8_BAR;
    PG8_BAR;
    if constexpr (Epi::AFTER_DRAIN) { E.fused(acc, cur, wr, wc, fr, fq, lds, wid, lane); }
#undef PG8_SA
#undef PG8_SB
#undef PG8_STAGE
#undef PG8_LDA
#undef PG8_LDB
#undef PG8_MMA
#undef PG8_WAIT_V
#undef PG8_WAIT_L
#undef PG8_BAR
#undef PG8_SCHED
}
}
using pg8::Unit;

struct Tok { int is_p, b, t, pos; };
__device__ __forceinline__ Tok tok_of(int m) { Tok k; if (m < NPT) { k.is_p = 1; k.b = m >> 12; k.t = m & 4095; k.pos = k.t; } else { const int s = m - NPT; k.is_p = 0; k.b = s >> 3; k.t = s & 7; k.pos = 2048 + k.t; } return k; }

template <class RM, class CM>
__device__ __forceinline__ void convT(bf16_t* dst, int ldd, int koff, int K, int nN, const float* src, int srcN, RM rowmap, CM colmap, size_t gtid, size_t gsz) {
    const size_t total = (size_t)nN * (K / 8);
    for (size_t i = gtid; i < total; i += gsz) {
        const int n = (int)(i % nN), kg = (int)(i / nN); const int c = colmap(n);
        float v[8];
#pragma unroll
        for (int j = 0; j < 8; ++j) v[j] = (c >= 0) ? src[(size_t)(kg * 8 + j) * srcN + c] : 0.f;
        u32x4 w; w.x = cvt_pk_bf16(v[0], v[1]); w.y = cvt_pk_bf16(v[2], v[3]); w.z = cvt_pk_bf16(v[4], v[5]); w.w = cvt_pk_bf16(v[6], v[7]);
        *(u32x4*)(dst + (size_t)rowmap(n) * ldd + koff + kg * 8) = w;
    }
}

template <class RM, class CM>
__device__ __forceinline__ void convTs(bf16_t* dst, int ldd, int koff, int K, int nN, const float* src, int srcN, const float* kscale, RM rowmap, CM colmap, size_t gtid, size_t gsz) {
    const unsigned total = (unsigned)nN * (unsigned)(K / 8), st = (unsigned)gsz;
#pragma unroll 1
    for (unsigned i0 = (unsigned)gtid; i0 < total; i0 += 4u * st) {
        float v[4][8];
#pragma unroll
        for (int q = 0; q < 4; ++q) { const unsigned i = i0 + (unsigned)q * st; const bool ok = i < total; const unsigned ii = ok ? i : 0u; const int n = (int)(ii % (unsigned)nN), kg = (int)(ii / (unsigned)nN); const int c = colmap(n);
#pragma unroll
            for (int j = 0; j < 8; ++j) v[q][j] = (c >= 0) ? src[(size_t)(kg * 8 + j) * srcN + c] : 0.f; }
#pragma unroll
        for (int q = 0; q < 4; ++q) { const unsigned i = i0 + (unsigned)q * st; if (i < total) { const int n = (int)(i % (unsigned)nN), kg = (int)(i / (unsigned)nN);
            f32x4 s0 = (f32x4){1.f, 1.f, 1.f, 1.f}, s1 = s0; if (kscale) { s0 = *(const f32x4*)(kscale + kg * 8); s1 = *(const f32x4*)(kscale + kg * 8 + 4); }
            u32x4 w; w.x = cvt_pk_bf16(v[q][0] * s0[0], v[q][1] * s0[1]); w.y = cvt_pk_bf16(v[q][2] * s0[2], v[q][3] * s0[3]); w.z = cvt_pk_bf16(v[q][4] * s1[0], v[q][5] * s1[1]); w.w = cvt_pk_bf16(v[q][6] * s1[2], v[q][7] * s1[3]);
            *(u32x4*)(dst + (size_t)rowmap(n) * ldd + koff + kg * 8) = w; } }
    }
}

template <class CM>
__device__ __forceinline__ void convT4(bf16_t* dst, int ldd, int K, int nN, const float* src, int srcN, CM colmap, size_t gtid, size_t gsz) {
    const unsigned n4s = (unsigned)nN / 4u, total = n4s * (unsigned)(K / 8);
#pragma unroll 1
    for (unsigned i = (unsigned)gtid; i < total; i += (unsigned)gsz) {
        const int n = (int)(i % n4s) * 4, kg = (int)(i / n4s); const int c = colmap(n);
        f32x4 v[8];
#pragma unroll
        for (int j = 0; j < 8; ++j) v[j] = (c >= 0) ? *(const f32x4*)(src + (size_t)(kg * 8 + j) * srcN + c) : (f32x4){0.f, 0.f, 0.f, 0.f};
#pragma unroll
        for (int e = 0; e < 4; ++e) { u32x4 w; w.x = cvt_pk_bf16(v[0][e], v[1][e]); w.y = cvt_pk_bf16(v[2][e], v[3][e]); w.z = cvt_pk_bf16(v[4][e], v[5][e]); w.w = cvt_pk_bf16(v[6][e], v[7][e]);
            *(u32x4*)(dst + (size_t)(n + e) * ldd + kg * 8) = w; }
    }
}

__device__ __forceinline__ void phase0(int bid, int nb) {
    CParams& p = kparams();
    const int tid = opaque_tid(), lane = tid & 63;
    const size_t gtid = (size_t)bid * NTHR + tid, gsz = (size_t)nb * NTHR;
    unsigned char* ws = p.ws;
    auto idm = [](int n) { return n; };
    convT4((bf16_t*)(ws + W_BT1), 1024, 1024, 5376, p.in[9], 5176,
          [](int n) { return n < 1824 ? n : (n < 1848 ? 3104 + (n - 1824) : (n < 2048 ? -1 : (n < 3328 ? 1824 + (n - 2048) : ((((n - 3328) >> 7) & 1) ? 4152 : 3128) + ((n - 3328) >> 8) * 128 + ((n - 3328) & 127)))); }, gtid, gsz);
    auto rot = [&](size_t off) -> size_t { return (gtid + gsz - off % gsz) % gsz; };
    for (int c = 0; c < 2; ++c)
        for (int hf = 0; hf < 2; ++hf)
            convT((bf16_t*)(ws + W_BTC1) + (size_t)(c * 256 + hf * 128) * 1024, 1024, 0, 1024, 128, p.in[22] + (size_t)(c * 2048 + hf * 1024) * 128, 128, idm, idm, rot((size_t)(c * 2 + hf) * 16384), gsz);
    for (int c = 0; c < 2; ++c) convT((bf16_t*)(ws + W_BTC2) + (size_t)c * 64 * 128, 128, 0, 128, 64, p.in[23] + (size_t)c * 128 * 64, 64, idm, idm, rot(65536 + (size_t)c * 1024), gsz);
    convT((bf16_t*)(ws + W_BTDEC), 64, 0, 64, 512, p.in[12], 512, idm, idm, rot(67584), gsz);
    convT((bf16_t*)(ws + W_BTAAA), 64, 0, 64, 512, p.in[14], 512, idm, idm, rot(71680), gsz);
    convT((bf16_t*)(ws + W_BTGATE), 160, 0, 160, 512, p.in[15], 512, idm, idm, rot(75776), gsz);
    for (size_t i = rot(86016); i < 4096 * 8; i += gsz) {
        const int pos = (int)(i >> 3), k = (int)(i & 7);
        const float inv = powf(500000.0f, -(float)k / 8.0f); const float ang = (float)pos * inv;
        float s, c; sincosf(ang, &s, &c);
        float* r = (float*)(ws + W_ROPE); r[i * 2] = c; r[i * 2 + 1] = s;
    }
    for (size_t i = gtid; i < (size_t)NTOK; i += gsz) { ((float*)(ws + W_RS1))[i] = 0.f; ((float*)(ws + W_RS2))[i] = 0.f; }
    {
        const int gw = (int)(gtid >> 6), nw = (int)(gsz >> 6);
        for (int o = gw; o < 512; o += nw) {
            const int c = o >> 8, n = o & 255, hf = n >> 7, hh = n & 127;
            const float* pe = p.in[21] + (size_t)(c * 32 + hf * 16) * 64; const float* w1 = p.in[22] + (size_t)(c * 2048 + hf * 1024) * 128 + hh;
            float s = 0.f, pv[16], wv2[16];
#pragma unroll
            for (int i = 0; i < 16; ++i) { const int k = lane + 64 * i; pv[i] = pe[k]; wv2[i] = w1[(size_t)k * 128]; }
#pragma unroll
            for (int i = 0; i < 16; ++i) s += pv[i] * wv2[i];
#pragma unroll
            for (int o2 = 32; o2 > 0; o2 >>= 1) s += __shfl_xor(s, o2);
            if (lane == 0) ((float*)(ws + W_BIASC))[o] = s;
        }
    }
    {
        const int gw = (int)(gtid >> 6), nw = (int)(gsz >> 6);
        const float* gm = p.in[8];
        f32x4 g[4];
#pragma unroll
        for (int j = 0; j < 4; ++j) g[j] = *(const f32x4*)(gm + j * 256 + lane * 4);
#pragma unroll 1
        for (int m0 = gw; m0 < NTOK; m0 += 4 * nw) {
            f32x4 v[4][4];
#pragma unroll
            for (int q = 0; q < 4; ++q) { const int mm = min(m0 + q * nw, NTOK - 1); const float* x = (mm < NPT) ? p.in[0] + (size_t)mm * 1024 : p.in[1] + (size_t)(mm - NPT) * 1024;
#pragma unroll
                for (int j = 0; j < 4; ++j) v[q][j] = *(const f32x4*)(x + j * 256 + lane * 4); }
#pragma unroll
            for (int q = 0; q < 4; ++q) { const int m = m0 + q * nw; if (m < NTOK) {
                float ss = 0.f;
#pragma unroll
                for (int j = 0; j < 4; ++j) ss += v[q][j][0] * v[q][j][0] + v[q][j][1] * v[q][j][1] + v[q][j][2] * v[q][j][2] + v[q][j][3] * v[q][j][3];
#pragma unroll
                for (int o2 = 32; o2 > 0; o2 >>= 1) ss += __shfl_xor(ss, o2);
                const float rs = rsqrtf(ss * (1.0f / 1024.0f) + 1e-6f);
                bf16_t* h = (bf16_t*)(ws + W_H) + (size_t)m * 1024;
#pragma unroll
                for (int j = 0; j < 4; ++j) *(u32x2*)(h + j * 256 + lane * 4) = pack4(v[q][j] * rs * g[j]); } }
        }
    }
}

__device__ __forceinline__ f32x4 rope4(f32x4 v, int fq, int pos, const float* rope) {
    f32x4 o;
#pragma unroll
    for (int j = 0; j < 4; ++j) {
        const float other = __shfl_xor(v[j], 32); const int i = 4 * (fq & 1) + j; const f32x2 cs = *(const f32x2*)(rope + pos * 16 + i * 2);
        o[j] = (fq < 2) ? v[j] * cs.x - other * cs.y : v[j] * cs.x + other * cs.y;
    }
    return o;
}

__device__ __forceinline__ f32x4 rope4c(f32x4 v, int fq, f32x4 c0, f32x4 c1) {
    f32x4 o;
#pragma unroll
    for (int j = 0; j < 4; ++j) {
        const float other = __shfl_xor(v[j], 32); const float cx = j < 2 ? c0[2 * (j & 1)] : c1[2 * (j & 1)], sx = j < 2 ? c0[2 * (j & 1) + 1] : c1[2 * (j & 1) + 1];
        o[j] = (fq < 2) ? v[j] * cx - other * sx : v[j] * cx + other * sx;
    }
    return o;
}
struct EpiG1 {
    static constexpr bool AFTER_DRAIN = false, HAS_MID = false; static constexpr int MID_T = 0;
    float* out; unsigned char* ws;
    __device__ __forceinline__ void mid(f32x4 (&)[2][2][4][2], const Unit&, int, int, int, int) const {}
    __device__ __forceinline__ void operator()(const f32x4 (&acc)[2][2][4][2], const Unit& u, int wr, int wc, int fr, int fq) const {
        const int pn = u.pn; const float* rope = (const float*)(ws + W_ROPE);
#pragma unroll
        for (int ai = 0; ai < 2; ++ai)
#pragma unroll
            for (int m = 0; m < 4; ++m) {
                const int row = u.pm * 256 + ai * 128 + wr * 64 + m * 16 + fr; const Tok tk = tok_of(row);
                f32x4 rc0 = (f32x4){0.f, 0.f, 0.f, 0.f}, rc1 = rc0;
                if (pn >= 8 && pn < 13 && pn != 10 && (wc & 1) == 0) { const float* rp = rope + tk.pos * 16 + 8 * (fq & 1); rc0 = *(const f32x4*)rp; rc1 = *(const f32x4*)(rp + 4); }
#pragma unroll
                for (int bj = 0; bj < 2; ++bj)
#pragma unroll
                    for (int n = 0; n < 2; ++n) {
                        const int cl = bj * 128 + wc * 32 + n * 16 + fq * 4; f32x4 v = acc[ai][bj][m][n];
                        if (pn < 8) {
                            const int c = pn * 256 + cl;
                            if (c < 1824) {
                                *(u32x2*)((bf16_t*)(ws + W_P) + (size_t)row * 1824 + c) = pack4(v);
                                if (tk.is_p) { if (tk.t == 4095) *(f32x4*)(out + O_PSHIFT + (size_t)tk.b * 1824 + c) = v; }
                                else { if (tk.t == 7) *(f32x4*)(out + O_SSHIFT + (size_t)tk.b * 1824 + c) = v; }
                            } else if (c < 1848) {
                                f32x4 s; s[0] = sigmoidf_(v[0]); s[1] = sigmoidf_(v[1]); s[2] = sigmoidf_(v[2]); s[3] = sigmoidf_(v[3]);
                                *(f32x4*)((float*)(ws + W_GN) + (size_t)row * 24 + (c - 1824)) = s;
                            }
                        } else if (pn < 10) {
                            const int c = (pn - 8) * 256 + cl; v = v * 0.18033688011112042f;
                            *(u32x2*)((bf16_t*)(ws + W_QC) + (size_t)row * 512 + c) = pack4(v);
                            if ((wc & 1) == 0 && n == 0) v = rope4c(v, fq, rc0, rc1);
                            *(u32x2*)((bf16_t*)(ws + W_QR) + (size_t)row * 512 + c) = pack4(v);
                        } else if (pn < 13) {
                            const int g = wc >> 1, d = (wc & 1) * 32 + n * 16 + fq * 4;
                            if (pn > 10 && bj == 0 && (wc & 1) == 0 && n == 0) v = rope4c(v, fq, rc0, rc1);
                            if (pn == 10) {
                                *(f32x4*)(out + (tk.is_p ? O_PCMP + (size_t)row * 256 : O_SCMP + (size_t)(row - NPT) * 256) + cl) = v;
                                if (tk.is_p) *(u32x2*)((bf16_t*)(ws + W_CPM) + (size_t)bj * 2048 * 1024 + (size_t)((tk.b * 2 + g) * 256 + (tk.t >> 4)) * 1024 + (tk.t & 15) * 64 + d) = pack4(v);
                            } else {
                                if (pn == 11) *(f32x4*)(out + (tk.is_p ? O_PSLC + (size_t)row * 256 : O_SSLC + (size_t)(row - NPT) * 256) + cl) = v;
                                else {
                                    if (tk.is_p) { if (tk.t >= 3584) *(f32x4*)(out + O_PWIN + ((size_t)tk.b * 512 + (tk.t - 3584)) * 256 + cl) = v; }
                                    else *(f32x4*)(out + O_SWIN + ((size_t)tk.b * 512 + 504 + tk.t) * 256 + cl) = v;
                                }
                                if (tk.is_p) {
                                    if (bj == 0) *(u32x2*)((bf16_t*)(ws + (pn == 11 ? W_KS : W_KW)) + ((size_t)(tk.b * 2 + g) * 4096 + tk.t) * 64 + d) = pack4(v);
                                    else { bf16_t* vt = (bf16_t*)(ws + (pn == 11 ? W_VST : W_VWT)) + ((size_t)(tk.b * 2 + g) * 64 + d) * 4096 + tk.t;
#pragma unroll
                                        for (int j = 0; j < 4; ++j) vt[(size_t)j * 4096] = f2bf(v[j]); }
                                }
                            }
                        } else if (bj == 0) {
                            const f32x4 vn = acc[ai][1][m][n]; f32x4 rt, sn;
#pragma unroll
                            for (int j = 0; j < 4; ++j) { const float eb1 = 1.0f + __expf(-vn[j]);
                                sn[j] = fmaxf(__builtin_amdgcn_rcpf(eb1), 1e-6f); rt[j] = sigmoidf_(v[j]) * fminf(eb1, 1e6f); }
                            const int col = (pn - 13) * 128 + wc * 32 + n * 16 + fq * 4;
                            *(u32x2*)((bf16_t*)(ws + W_GATES) + (size_t)row * 2048 + col) = pack4(rt);
                            *(u32x2*)((bf16_t*)(ws + W_GATES) + (size_t)row * 2048 + 1024 + col) = pack4(sn);
                        }
                    }
            }
    }
};

struct EpiCmp {
    static constexpr bool AFTER_DRAIN = true, HAS_MID = false; static constexpr int MID_T = 0;
    unsigned char* ws; int gs  ; int per_c  ; bf16_t* KC; bf16_t* VCT;
    __device__ __forceinline__ void mid(f32x4 (&)[2][2][4][2], const Unit&, int, int, int, int) const {}
    __device__ __forceinline__ void operator()(const f32x4 (&)[2][2][4][2], const Unit&, int, int, int, int) const {}
    __device__ __forceinline__ void fused(f32x4 (&acc)[2][2][4][2], const Unit& u, int wr, int wc, int fr, int fq, LAS unsigned char* lds, int wid, int lane) const {
        const int c = u.pn, pmr = u.pm - c * per_c;
        LAS float* HS = (LAS float*)lds;
        LAS bf16_t* HB = (LAS bf16_t*)lds;
        const float* bias = (const float*)(ws + W_BIASC) + c * 256;
#pragma unroll
        for (int ai = 0; ai < 2; ++ai)
#pragma unroll
            for (int m = 0; m < 4; ++m) { const int rl = ai * 128 + wr * 64 + m * 16 + fr;
#pragma unroll
                for (int n = 0; n < 2; ++n) *(LAS f32x4*)(HS + rl * 132 + wc * 32 + n * 16 + fq * 4) = acc[ai][1][m][n]; }
        __syncthreads();
#pragma unroll
        for (int ai = 0; ai < 2; ++ai)
#pragma unroll
            for (int m = 0; m < 4; ++m) { const int rl = ai * 128 + wr * 64 + m * 16 + fr; const bool ok = (rl % gs) < gs - 1;
#pragma unroll
                for (int n = 0; n < 2; ++n) { const int h = wc * 32 + n * 16 + fq * 4;
                    f32x4 r = (f32x4){0.f, 0.f, 0.f, 0.f};
                    if (ok) { const f32x4 hs = *(const LAS f32x4*)(HS + (rl + 1) * 132 + h); const f32x4 b0 = *(const f32x4*)(bias + h), b1 = *(const f32x4*)(bias + 128 + h);
                        const f32x4 x = acc[ai][0][m][n] + hs + b0 + b1;
#pragma unroll
                        for (int j = 0; j < 4; ++j) r[j] = x[j] * sigmoidf_(x[j]); }
                    acc[ai][0][m][n] = r; } }
        __syncthreads();
#pragma unroll
        for (int ai = 0; ai < 2; ++ai)
#pragma unroll
            for (int m = 0; m < 4; ++m) { const int rl = ai * 128 + wr * 64 + m * 16 + fr;
#pragma unroll
                for (int n = 0; n < 2; ++n) *(LAS u32x2*)(HB + rl * 136 + wc * 32 + n * 16 + fq * 4) = pack4(acc[ai][0][m][n]); }
        __syncthreads();
        const bf16_t* w2 = (const bf16_t*)(ws + W_BTC2) + (size_t)c * 64 * 128;
        bf16x8 wfr[4][4];
#pragma unroll
        for (int ct = 0; ct < 4; ++ct)
#pragma unroll
            for (int ks = 0; ks < 4; ++ks) wfr[ct][ks] = *(const bf16x8*)(w2 + (size_t)(ct * 16 + fr) * 128 + ks * 32 + fq * 8);
#pragma unroll
        for (int rt = 0; rt < 2; ++rt) {
            bf16x8 hfr[4];
#pragma unroll
            for (int ks = 0; ks < 4; ++ks) hfr[ks] = *(const LAS bf16x8*)(HB + (wid * 32 + rt * 16 + fr) * 136 + ks * 32 + fq * 8);
#pragma unroll
            for (int ct = 0; ct < 4; ++ct) {
                f32x4 d = (f32x4){0.f, 0.f, 0.f, 0.f};
#pragma unroll
                for (int ks = 0; ks < 4; ++ks) { const bf16x8 wf = wfr[ct][ks];
                    d = (c == 0) ? mfma16(wf, hfr[ks], d) : mfma16(hfr[ks], wf, d); }
                if (c == 0) {
                    const size_t Rg = (size_t)pmr * 256 + wid * 32 + rt * 16 + fr;
                    *(u32x2*)(KC + Rg * 64 + ct * 16 + fq * 4) = pack4(d);
                } else {
                    const size_t Rg = (size_t)pmr * 256 + wid * 32 + rt * 16 + fq * 4; const size_t pair = Rg / gs, nn = Rg % gs;
                    *(u32x2*)(VCT + (pair * 64 + ct * 16 + fr) * gs + nn) = pack4(d);
                }
            }
        }
        __syncthreads();
    }
};

constexpr unsigned SWIN_TOTAL = 128u * 504u * 64u, SWIN_SPLIT = (SWIN_TOTAL / 4u) * 3u;
__device__ __forceinline__ void swin_copy(CParams& p, int part, int nparts, unsigned lo, unsigned total) {
    const f32x4* src = (const f32x4*)p.in[4]; f32x4* dst = (f32x4*)(p.out + O_SWIN);
    const unsigned stride = (unsigned)nparts * NTHR;
    unsigned i = lo + (unsigned)part * NTHR + (unsigned)opaque_tid();
    for (; i + 3u * stride < total; i += 4u * stride) {
        unsigned o[4]; f32x4 v[4];
#pragma unroll
        for (int j = 0; j < 4; ++j) { const unsigned ii = i + (unsigned)j * stride, b = ii / (504u * 64u), r = ii - b * (504u * 64u); o[j] = b * (512u * 64u) + r; v[j] = src[o[j] + 8u * 64u]; }
#pragma unroll
        for (int j = 0; j < 4; ++j) dst[o[j]] = v[j];
    }
    for (; i < total; i += stride) { const unsigned b = i / (504u * 64u), r = i - b * (504u * 64u); dst[b * (512u * 64u) + r] = src[b * (512u * 64u) + 8u * 64u + r]; }
}
__device__ __forceinline__ void csm_gather(CParams& p, int uidx) {
    const int tid = opaque_tid(), d8 = tid & 7, g = (tid >> 3) & 1, r0 = tid >> 4;
    const int c = uidx >> 7, seq = uidx & 127;
    const int* pt = (const int*)p.in[7] + seq * 16;
    const float* cc = p.in[2] + c * 128 + g * 64 + d8 * 8;
    bf16_t* dst = (bf16_t*)(p.ws + W_CSM) + ((size_t)c * 32768 + (size_t)(seq * 2 + g) * 128) * 1024 + d8 * 8;
#pragma unroll 1
    for (int it = 0; it < 4; ++it) {
        f32x4 a[16], b[16];
#pragma unroll
        for (int j = 0; j < 16; ++j) { const int rowi = it * 512 + j * 32 + r0; const int page = pt[it * 4 + (j >> 2)];
            const float* src = cc + ((size_t)page * 128 + (rowi & 127)) * 256; a[j] = *(const f32x4*)src; b[j] = *(const f32x4*)(src + 4); }
#pragma unroll
        for (int j = 0; j < 16; ++j) { const int rowi = it * 512 + j * 32 + r0;
            u32x4 w; w.x = cvt_pk_bf16(a[j][0], a[j][1]); w.y = cvt_pk_bf16(a[j][2], a[j][3]); w.z = cvt_pk_bf16(b[j][0], b[j][1]); w.w = cvt_pk_bf16(b[j][2], b[j][3]);
            *(u32x4*)(dst + (size_t)(rowi >> 4) * 1024 + (rowi & 15) * 64) = w; }
    }
    asm volatile("s_waitcnt vmcnt(0)" ::: "memory");
    __syncthreads();
}
__device__ __forceinline__ void phase1(LAS unsigned char* lds, int bid, int nb) {
    CParams& p = kparams();
    const int ksplit = bid % 7;
#pragma unroll 1
    for (int s = 0; s < 3; ++s) {
        if (s == 1) {
            pg8::Gemm g{(const bf16_t*)(p.ws + W_CSM), (const bf16_t*)(p.ws + W_BTC1), 65536, 512, 1024};
            EpiCmp E{p.ws, 128, 128, (bf16_t*)(p.ws + W_KCS), (bf16_t*)(p.ws + W_VCST)};
            for (int uidx = bid; uidx < 256; uidx += nb) { csm_gather(p, uidx); pg8::OneUnit S{{uidx, uidx >> 7}}; pg8::gemm_phase(lds, g, S, E); }
        } else {
            pg8::Gemm g{(const bf16_t*)(p.ws + W_H), (const bf16_t*)(p.ws + W_BT1), NTOK, 5376, 1024};
            pg8::StaticOrder S; S.init(NTOK, 5376, nb, bid); if (s == 0) S.i1 = ksplit; else S.i0 = ksplit;
            EpiG1 E{p.out, p.ws};
            pg8::gemm_phase(lds, g, S, E);
        }
    }
    {
        const int first = ((NTOK / 256) * 21) % nb;
        if (bid >= first) swin_copy(p, bid - first, nb - first, 0u, SWIN_SPLIT);
    }
}

struct PrepRow { const unsigned char* pb; unsigned po; bool hasprev; const float* shift0; const float* mu; };
__device__ __forceinline__ f32x8 prep_xs8(const PrepRow& R, int c0) {
    const f32x8 pc = ld_bf8((const bf16_t*)(R.pb + (R.po + (unsigned)c0 * 2u))); f32x8 pp;
    if (R.hasprev) pp = ld_bf8((const bf16_t*)(R.pb + (R.po - 3648u + (unsigned)c0 * 2u)));
    else if (R.shift0) { const f32x4 a = *(const f32x4*)(R.shift0 + c0), b = *(const f32x4*)(R.shift0 + c0 + 4); pp = (f32x8){a[0], a[1], a[2], a[3], b[0], b[1], b[2], b[3]}; }
    else pp = (f32x8){0.f, 0.f, 0.f, 0.f, 0.f, 0.f, 0.f, 0.f};
    const f32x4 m0 = *(const f32x4*)(R.mu + c0), m1 = *(const f32x4*)(R.mu + c0 + 4);
    const f32x8 m = (f32x8){m0[0], m0[1], m0[2], m0[3], m1[0], m1[1], m1[2], m1[3]};
    return pc + (pp - pc) * m;
}
__device__ __forceinline__ f32x4 prep_xs4(const PrepRow& R, int c0) {
    const f32x4 pc = ld_bf4((const bf16_t*)(R.pb + (R.po + (unsigned)c0 * 2u))); f32x4 pp;
    if (R.hasprev) pp = ld_bf4((const bf16_t*)(R.pb + (R.po - 3648u + (unsigned)c0 * 2u)));
    else if (R.shift0) pp = *(const f32x4*)(R.shift0 + c0);
    else pp = (f32x4){0.f, 0.f, 0.f, 0.f};
    const f32x4 m = *(const f32x4*)(R.mu + c0);
    return pc + (pp - pc) * m;
}

#define PREP_ST(arr, nc, val) (*(u32x2*)(ws + (arr) + (om + (unsigned)(nc) * 2u)) = pack4(val))
struct PrepTile { bf16x8 wd[2], wa[2], wg[5]; f32x4 xr, xk, xv, w0, a0, k_k, k_a, rkv; };
__device__ __forceinline__ void prep_ld(PrepTile& t, CParams& p, const PrepRow& R, const bf16_t* Wd, const bf16_t* Wa, const bf16_t* Wg, int n0, int fr, int fq) {
    const int nc = n0 + 4 * fq;
#pragma unroll
    for (int ks = 0; ks < 2; ++ks) { t.wd[ks] = *(const bf16x8*)(Wd + (size_t)(n0 + fr) * 64 + ks * 32 + fq * 8); t.wa[ks] = *(const bf16x8*)(Wa + (size_t)(n0 + fr) * 64 + ks * 32 + fq * 8); }
#pragma unroll
    for (int ks = 0; ks < 5; ++ks) t.wg[ks] = *(const bf16x8*)(Wg + (size_t)(n0 + fr) * 160 + ks * 32 + fq * 8);
    t.xr = prep_xs4(R, nc); t.xk = prep_xs4(R, 576 + nc); t.xv = prep_xs4(R, 1088 + nc);
    t.w0 = *(const f32x4*)(p.in[11] + nc); t.a0 = *(const f32x4*)(p.in[13] + nc); t.k_k = *(const f32x4*)(p.in[16] + nc); t.k_a = *(const f32x4*)(p.in[17] + nc); t.rkv = *(const f32x4*)(p.in[18] + nc);
}
__device__ __forceinline__ float prep_tile(const PrepTile& t, const bf16x8 (&Adec)[2], const bf16x8 (&Aaaa)[2], const bf16x8 (&Agate)[5], LAS unsigned char* lw, int lcol, float inv) {
    f32x4 aw = (f32x4){0.f, 0.f, 0.f, 0.f}, a_a = aw, ag = aw;
#pragma unroll
    for (int ks = 0; ks < 2; ++ks) { aw = mfma16(t.wd[ks], Adec[ks], aw); a_a = mfma16(t.wa[ks], Aaaa[ks], a_a); }
#pragma unroll
    for (int ks = 0; ks < 5; ++ks) ag = mfma16(t.wg[ks], Agate[ks], ag);
    f32x4 dec, av;
#pragma unroll
    for (int j = 0; j < 4; ++j) {
        const float z = -(t.w0[j] + aw[j]);
        const float sp = fmaxf(z, 0.f) + __logf(1.0f + __expf(-fabsf(z)));
        dec[j] = -__expf(-sp - 0.5f);
        av[j] = sigmoidf_(t.a0[j] + a_a[j]);
    }
    const f32x4 kkn = t.xk * t.k_k * inv;
    const f32x4 khv = t.xk * (1.0f + (av - 1.0f) * t.k_a);
    const f32x4 bt = t.xr * khv * t.rkv;
#define PREP_LST(ai, val) (*(LAS u32x2*)(lw + (ai) * 2304 + lcol * 2) = pack4(val))
    PREP_LST(0, t.xr); PREP_LST(1, dec); PREP_LST(2, khv); PREP_LST(3, t.xv); PREP_LST(4, -kkn); PREP_LST(5, kkn * av); PREP_LST(6, ag);
#undef PREP_LST
    return (bt[0] + bt[1]) + (bt[2] + bt[3]);
}
__device__ __forceinline__ void chunk_ops_wave(unsigned char* ws, LAS unsigned char* ldsw, int gc, int lane) {
    unsigned char* ob = ws + W_COP + (size_t)gc * 18432;
    LAS bf16_t* IMG = (LAS bf16_t*)ldsw;
    LAS float* M01 = (LAS float*)(ldsw + 1 * 2304); LAS float* M23 = (LAS float*)(ldsw + 3 * 2304); LAS float* MTT = (LAS float*)(ldsw + 6 * 2304);
    {
        const int j = lane;
        float Lc[17]; Lc[0] = 0.f;
#pragma unroll
        for (int t = 0; t < 16; ++t) Lc[t + 1] = Lc[t] + bf2f(IMG[1 * 1152 + t * 72 + j]);
        const float Lm = Lc[8], LC = Lc[16], em = __expf(-Lm);
        unsigned btp[8], ktp[8], vtp[8];
#pragma unroll
        for (int t2 = 0; t2 < 8; ++t2) {
            float bts[2], kts[2], vts[2];
#pragma unroll
            for (int e = 0; e < 2; ++e) { const int t = 2 * t2 + e;
                const float rr = bf2f(IMG[0 * 1152 + t * 72 + j]), kk = bf2f(IMG[2 * 1152 + t * 72 + j]), vv = bf2f(IMG[3 * 1152 + t * 72 + j]), aa = bf2f(IMG[4 * 1152 + t * 72 + j]), bb = bf2f(IMG[5 * 1152 + t * 72 + j]);
                const float Lt = Lc[t + 1], Lp = Lc[t];
                const float ah = aa * __expf(Lp), rh = rr * __expf(Lt), en = __expf(Lm - Lt), es = __expf(LC - Lt);
                IMG[4 * 1152 + t * 72 + j] = f2bf(ah * em); IMG[0 * 1152 + t * 72 + j] = f2bf(rh * em); IMG[5 * 1152 + t * 72 + j] = f2bf(bb * en); IMG[2 * 1152 + t * 72 + j] = f2bf(kk * en);
                ((bf16_t*)(ob + 0))[t * 72 + j] = f2bf(ah); ((bf16_t*)(ob + 0))[(16 + t) * 72 + j] = f2bf(rh);
                bts[e] = bb * es; kts[e] = kk * es; vts[e] = vv; }
            btp[t2] = cvt_pk_bf16(bts[0], bts[1]); ktp[t2] = cvt_pk_bf16(kts[0], kts[1]); vtp[t2] = cvt_pk_bf16(vts[0], vts[1]);
        }
        *(u32x4*)(ob + 8704 + j * 48) = (u32x4){btp[0], btp[1], btp[2], btp[3]}; *(u32x4*)(ob + 8704 + j * 48 + 16) = (u32x4){btp[4], btp[5], btp[6], btp[7]};
        *(u32x4*)(ob + 11776 + j * 48) = (u32x4){ktp[0], ktp[1], ktp[2], ktp[3]}; *(u32x4*)(ob + 11776 + j * 48 + 16) = (u32x4){ktp[4], ktp[5], ktp[6], ktp[7]};
        *(u32x4*)(ob + 14848 + j * 48) = (u32x4){vtp[0], vtp[1], vtp[2], vtp[3]}; *(u32x4*)(ob + 14848 + j * 48 + 16) = (u32x4){vtp[4], vtp[5], vtp[6], vtp[7]};
        ((float*)(ob + 17920))[j] = __expf(LC);
    }
    asm volatile("s_waitcnt lgkmcnt(0)" ::: "memory");
    {
        const int r = lane & 31, h = lane >> 5;
        LAS const bf16_t* hb = IMG + ((r < 16) ? 5 : 2) * 1152 + (r & 15) * 72 + h * 8; LAS const bf16_t* ha = IMG + ((r < 16) ? 4 : 0) * 1152 + (r & 15) * 72 + h * 8;
        f32x16 D;
#pragma unroll
        for (int i2 = 0; i2 < 16; ++i2) D[i2] = 0.f;
        bf16x8 fa[4], fb[4];
#pragma unroll
        for (int ks = 0; ks < 4; ++ks) { fa[ks] = *(const LAS bf16x8*)(hb + ks * 16); fb[ks] = *(const LAS bf16x8*)(ha + ks * 16); }
#pragma unroll
        for (int ks = 0; ks < 4; ++ks) D = mfma32(fa[ks], fb[ks], D);
        asm volatile("s_waitcnt lgkmcnt(0)" ::: "memory");
        const int y = r;
#pragma unroll
        for (int reg = 0; reg < 16; ++reg) { const int x = (reg & 3) + 8 * (reg >> 2) + 4 * h;
            const int xx = x & 15, yy = y & 15; const bool nz = (y < 16) ? (xx < yy) : (xx <= yy);
            LAS float* dst = (y < 16) ? M01 : M23;
            dst[(x >> 4) * 256 + xx * 16 + yy] = nz ? D[reg] : 0.f; }
    }
    asm volatile("s_waitcnt lgkmcnt(0)" ::: "memory");
    if (lane < 16) {
        const int tau = lane; float T[16];
#pragma unroll
        for (int s = 0; s < 16; ++s) { float v = (s == tau) ? 1.f : 0.f;
#pragma unroll
            for (int sg = 0; sg < s; ++sg) v += (sg >= tau) ? T[sg] * M01[sg * 16 + s] : 0.f;
            T[s] = v; }
#pragma unroll
        for (int s = 0; s < 16; ++s) MTT[tau * 16 + s] = T[s];
    }
    asm volatile("s_waitcnt lgkmcnt(0)" ::: "memory");
    {
#pragma unroll 4
        for (int k = 0; k < 16; ++k) { const int e = lane + 64 * k; const int row = e >> 5, col = e & 31; float v;
            if (row < 16) v = (col < 16) ? MTT[col * 16 + row] : 0.f;
            else { const int t = row - 16;
                if (col < 16) { v = 0.f;
#pragma unroll
                    for (int s = 0; s < 16; ++s) v += M23[s * 16 + t] * MTT[col * 16 + s]; }
                else v = (col - 16 == t) ? 1.f : 0.f; }
            ((bf16_t*)(ob + 6144))[row * 40 + col] = f2bf(v); }
#pragma unroll
        for (int k = 0; k < 8; ++k) { const int e = lane + 64 * k; const int row = e >> 4, col = e & 15;
            const float v = (row < 16) ? M01[256 + col * 16 + row] : M23[256 + col * 16 + (row - 16)];
            ((bf16_t*)(ob + 4608))[row * 24 + col] = f2bf(v); }
    }
    asm volatile("s_waitcnt lgkmcnt(0)" ::: "memory");
}

__device__ __forceinline__ void prep_item(CParams& p, LAS unsigned char* ldsw, int grp, int hp, int lane_in, int hh0, int hh1) {
    unsigned char* ws = p.ws;
    int lane = lane_in; asm volatile("" : "+v"(lane));
    const int fr = lane & 15, fq = lane >> 4;
    const int m = grp * 16 + fr; const Tok tk = tok_of(m);
    PrepRow R; R.pb = ws + W_P; R.po = (unsigned)m * 3648u; R.hasprev = tk.t > 0;
    R.shift0 = (!tk.is_p && tk.t == 0) ? p.in[6] + (size_t)tk.b * 1824 : nullptr; R.mu = p.in[10];
    bf16x8 Adec[2], Aaaa[2], Agate[5];
    {
        f32x8 xd[2], xa[2];
#pragma unroll
        for (int ks = 0; ks < 2; ++ks) { xd[ks] = prep_xs8(R, 512 + ks * 32 + fq * 8); xa[ks] = prep_xs8(R, 1600 + ks * 32 + fq * 8); }
#pragma unroll
        for (int ks = 0; ks < 2; ++ks) {
            const f32x8 x = xd[ks], y = xa[ks];
            Adec[ks] = pack8(tanhf_(x[0]), tanhf_(x[1]), tanhf_(x[2]), tanhf_(x[3]), tanhf_(x[4]), tanhf_(x[5]), tanhf_(x[6]), tanhf_(x[7]));
            Aaaa[ks] = pack8(y[0], y[1], y[2], y[3], y[4], y[5], y[6], y[7]);
        }
        __builtin_amdgcn_sched_barrier(0);
#pragma unroll
        for (int ks = 0; ks < 5; ++ks) { const f32x8 x = prep_xs8(R, 1664 + ks * 32 + fq * 8);
            Agate[ks] = pack8(sigmoidf_(x[0]), sigmoidf_(x[1]), sigmoidf_(x[2]), sigmoidf_(x[3]), sigmoidf_(x[4]), sigmoidf_(x[5]), sigmoidf_(x[6]), sigmoidf_(x[7])); }
        __builtin_amdgcn_sched_barrier(0);
    }
    const bf16_t* Wd = (const bf16_t*)(ws + W_BTDEC); const bf16_t* Wa = (const bf16_t*)(ws + W_BTAAA); const bf16_t* Wg = (const bf16_t*)(ws + W_BTGATE);
    const unsigned om = (unsigned)m * 1024u;
#pragma unroll 1
    for (int hh = hh0; hh < hh1; ++hh) {
        const int h = hp * 2 + hh;
        float ss = 0.f;
#pragma unroll
        for (int nt = 0; nt < 4; ++nt) { const int nc = h * 64 + nt * 16 + 4 * fq; const f32x4 kr = prep_xs4(R, 576 + nc) * *(const f32x4*)(p.in[16] + nc); ss += (kr[0] * kr[0] + kr[1] * kr[1]) + (kr[2] * kr[2] + kr[3] * kr[3]); }
        ss += __shfl_xor(ss, 16); ss += __shfl_xor(ss, 32);
        const float inv = rsqrtf(fmaxf(ss, 1e-24f));
        float bsum = 0.f;
#pragma unroll 1
        for (int nt = 0; nt < 4; ++nt) {
            PrepTile tA;
            prep_ld(tA, p, R, Wd, Wa, Wg, h * 64 + nt * 16, fr, fq);
            bsum += prep_tile(tA, Adec, Aaaa, Agate, ldsw + fr * 144, nt * 16 + 4 * fq, inv);
        }
        __builtin_amdgcn_sched_barrier(0);
        const bool prompt = grp < (NPT / 16);
#pragma unroll 1
        for (int ai = 0; ai < 7; ++ai) {
            if (prompt && ai != 3 && ai != 6) continue;
#pragma unroll
            for (int ps = 0; ps < 2; ++ps) { const int tk2 = ps * 8 + (lane >> 3), c8 = lane & 7;
                const u32x4 v = *(LAS const u32x4*)(ldsw + ai * 2304 + tk2 * 144 + c8 * 16);
                *(u32x4*)(ws + W_R + (size_t)ai * RW_SZ + ((size_t)(grp * 16 + tk2) * 512 + h * 64 + c8 * 8) * 2) = v; }
        }
        if (prompt) { asm volatile("s_waitcnt lgkmcnt(0)" ::: "memory"); chunk_ops_wave(ws, ldsw, ((grp >> 8) * 8 + h) * 256 + (grp & 255), lane); }
        bsum += __shfl_xor(bsum, 16); bsum += __shfl_xor(bsum, 32);
        if (fq == 0) ((float*)(ws + W_BON))[(size_t)m * 8 + h] = bsum;
    }
}

__device__ __forceinline__ void phase2(LAS unsigned char* lds, int bid, int nb) {
    CParams& p = kparams();
    {
        pg8::Gemm g{(const bf16_t*)(p.ws + W_CPM), (const bf16_t*)(p.ws + W_BTC1), 4096, 512, 1024};
        EpiCmp E{p.ws, 256, 8, (bf16_t*)(p.ws + W_KCP), (bf16_t*)(p.ws + W_VCPT)};
        for (int uidx = bid; uidx < 16; uidx += nb) { pg8::OneUnit S{{uidx, uidx >> 3}}; pg8::gemm_phase(lds, g, S, E); }
    }
    const int tid2 = opaque_tid(); const int wv = tid2 >> 6, lane = tid2 & 63;
    const int skip = nb > 32 ? 16 : 0;
    if (bid < skip || skip == 0) swin_copy(p, bid, skip ? skip : nb, SWIN_SPLIT, SWIN_TOTAL);
    const int nitems = (NTOK / 16) * 4, nwaves = (nb - skip) * 8, nfull = (nitems / nwaves) * nwaves, nhalf = (nitems - nfull) * 2;
    if (bid >= skip) { const int w0 = (bid - skip) * 8 + wv;
#pragma unroll 1
        for (int k = w0; k < nfull + nhalf; k += nwaves) { const bool full = k < nfull; const int j = k - nfull, it = full ? k : nfull + (j >> 1), hh0 = full ? 0 : (j & 1);
            prep_item(p, lds + wv * 16128, it >> 2, it & 3, lane, hh0, full ? 2 : hh0 + 1); } }
    const int light0 = skip + ((nhalf < nwaves ? nhalf : 0) + 7) / 8;
    if (bid >= light0) {
        unsigned char* ws = p.ws;
        const size_t gtid = (size_t)(bid - light0) * NTHR + opaque_tid(), gsz = (size_t)(nb - light0) * NTHR;
        auto idm = [](int n) { return n; };
        convTs((bf16_t*)(ws + W_BTM), 1024, 0, 512, 1024, p.in[24], 1024, nullptr, idm, idm, gtid, gsz);
        convTs((bf16_t*)(ws + W_BTM), 1024, 512, 512, 1024, p.in[25], 1024, nullptr, idm, idm, gtid, gsz);
        convTs((bf16_t*)(ws + W_BTO), 1024, 0, 1024, 1024, p.in[26], 1024, nullptr, idm, idm, gtid, gsz);
        convTs((bf16_t*)(ws + W_BTGU), 1024, 0, 1024, 2816, p.in[28], 2816, p.in[27], [](int n) { return 256 * (n >> 7) + (n & 127); }, idm, gtid, gsz);
        convTs((bf16_t*)(ws + W_BTGU), 1024, 0, 1024, 2816, p.in[29], 2816, p.in[27], [](int n) { return 256 * (n >> 7) + 128 + (n & 127); }, idm, gtid, gsz);
        convTs((bf16_t*)(ws + W_BTD), 2816, 0, 2816, 1024, p.in[30], 1024, nullptr, idm, idm, gtid, gsz);
    }
}

__device__ __forceinline__ float allreduce16(float x) {
    x += dppf(x, 0); x += dppf(x, 1); x += dppf(x, 2);
    x += __int_as_float(__builtin_amdgcn_update_dpp(0, __float_as_int(x), 0x140, 0xF, 0xF, false));
    return x;
}
__device__ __forceinline__ void scan_unit(CParams& p, LAS unsigned char* lds, int unit) {
    unsigned char* ws = p.ws;
    const int tid = opaque_tid(), il = tid >> 4, q = tid & 15;
    int T, m0, h, half; const float* S0 = nullptr; float* Sout;
    if (unit < 64) { const int bh = unit >> 1; half = unit & 1; const int b = bh >> 3; h = bh & 7; T = 4096; m0 = b * 4096; Sout = p.out + O_PRWKV + (size_t)bh * 4096; }
    else { const int su = unit - 64; const int bh = su >> 1; half = su & 1; const int seq = bh >> 3; h = bh & 7; T = 8; m0 = NPT + seq * 8; S0 = p.in[5] + (size_t)bh * 4096; Sout = p.out + O_SRWKV + (size_t)bh * 4096; }
    const int i = half * 32 + il;
    LAS float* buf = (LAS float*)lds;
    f32x4 S = (f32x4){0.f, 0.f, 0.f, 0.f};
    if (S0) S = *(const f32x4*)(S0 + i * 64 + q * 4);
    const int nch = (T + 15) >> 4;
    f32x4 stg[3];
    auto gload = [&](int c) {
#pragma unroll
        for (int k = 0; k < 3; ++k) { const int idx = tid + 512 * k; const int ar = idx >> 8, st = (idx >> 4) & 15, f4 = idx & 15; const int t = c * 16 + st;
            f32x4 vv = (f32x4){0.f, 0.f, 0.f, 0.f};
            if (t < T) { vv = ld_bf4((const bf16_t*)(ws + W_R + (size_t)ar * RW_SZ) + (size_t)(m0 + t) * 512 + h * 64 + f4 * 4);
                if (ar == 1) { vv[0] = __expf(vv[0]); vv[1] = __expf(vv[1]); vv[2] = __expf(vv[2]); vv[3] = __expf(vv[3]); } }
            stg[k] = vv; }
    };
    auto lstore = [&](int bi) {
#pragma unroll
        for (int k = 0; k < 3; ++k) { const int idx = tid + 512 * k; const int ar = idx >> 8, st = (idx >> 4) & 15, f4 = idx & 15;
            *(LAS f32x4*)(buf + ((bi * 6 + ar) * 16 + st) * 64 + f4 * 4) = stg[k]; }
    };
    __syncthreads();
    gload(0); lstore(0);
    __syncthreads();
    float* yout = (float*)(ws + W_YRAW) + (size_t)m0 * 512 + h * 64 + i;
    for (int c = 0; c < nch; ++c) {
        const int bi = c & 1; const int ns = (T - c * 16) < 16 ? (T - c * 16) : 16;
        if (c + 1 < nch) gload(c + 1);
        LAS const float* bb = buf + bi * 6 * 16 * 64;
        for (int s = 0; s < ns; ++s) {
            const f32x4 rv = *(LAS const f32x4*)(bb + (0 * 16 + s) * 64 + q * 4);
            const f32x4 dv = *(LAS const f32x4*)(bb + (1 * 16 + s) * 64 + q * 4);
            const f32x4 kv = *(LAS const f32x4*)(bb + (2 * 16 + s) * 64 + q * 4);
            const float vi = bb[(3 * 16 + s) * 64 + i];
            const f32x4 av = *(LAS const f32x4*)(bb + (4 * 16 + s) * 64 + q * 4);
            const f32x4 bv = *(LAS const f32x4*)(bb + (5 * 16 + s) * 64 + q * 4);
            const f32x4 sa4 = S * av;
            const float sa = allreduce16((sa4[0] + sa4[1]) + (sa4[2] + sa4[3]));
            S = S * dv + bv * sa + kv * vi;
            const f32x4 y4 = S * rv;
            const float y = allreduce16((y4[0] + y4[1]) + (y4[2] + y4[3]));
            if (q == 0) yout[(size_t)(c * 16 + s) * 512] = y;
        }
        __syncthreads();
        if (c + 1 < nch) lstore(bi ^ 1);
        __syncthreads();
    }
    *(f32x4*)(Sout + i * 64 + q * 4) = S;
}

struct ScanOps { f32x4 rv, dv, kv, av, bv; float vi; };
__device__ __forceinline__ void scan_ldops(ScanOps& o, LAS const float* bb, int s, int q, int i) {
    o.rv = *(LAS const f32x4*)(bb + (0 * 16 + s) * 64 + q * 4); o.dv = *(LAS const f32x4*)(bb + (1 * 16 + s) * 64 + q * 4);
    o.kv = *(LAS const f32x4*)(bb + (2 * 16 + s) * 64 + q * 4); o.vi = bb[(3 * 16 + s) * 64 + i];
    o.av = *(LAS const f32x4*)(bb + (4 * 16 + s) * 64 + q * 4); o.bv = *(LAS const f32x4*)(bb + (5 * 16 + s) * 64 + q * 4);
}
__device__ __forceinline__ void scan_step(f32x4& S, const ScanOps& o, LAS float* yb) {
    const f32x4 sa4 = S * o.av;
    const f32x4 tt = S * o.dv + o.kv * o.vi;
    const float sa = allreduce16((sa4[0] + sa4[1]) + (sa4[2] + sa4[3]));
    S = o.bv * sa + tt;
    const f32x4 y4 = S * o.rv;
    *yb = (y4[0] + y4[1]) + (y4[2] + y4[3]);
}
__device__ __forceinline__ void scan_unit16(CParams& p, LAS unsigned char* lds, int unit) {
    unsigned char* ws = p.ws;
    const int tid = opaque_tid();
    const int bh = unit >> 2, quarter = unit & 3, b = bh >> 3, h = bh & 7;
    const int m0 = b * 4096;
    const bool comp = tid < 256;
    const int il = (tid >> 4) & 15, q = tid & 15, i = quarter * 16 + il, lt = tid & 255;
    LAS float* buf = (LAS float*)lds; LAS float* ybuf = buf + 2 * 6 * 16 * 64;
    f32x4 S = (f32x4){0.f, 0.f, 0.f, 0.f};
    const bf16_t* gbase = (const bf16_t*)(ws + W_R) + (size_t)m0 * 512 + h * 64 + (size_t)((lt >> 4) & 15) * 512 + (lt & 15) * 4;
    LAS float* lbase = buf + ((lt >> 4) & 15) * 64 + (lt & 15) * 4;
    float* ybase = (float*)(ws + W_YRAW) + (size_t)m0 * 512 + h * 64 + quarter * 16 + (size_t)(lt >> 4) * 512 + (lt & 15);
    auto stage = [&](int c) {
        u32x2 t[6];
#pragma unroll
        for (int k = 0; k < 6; ++k) t[k] = *(const u32x2*)(gbase + (size_t)k * (RW_SZ / 2) + (size_t)c * 16 * 512);
#pragma unroll
        for (int k = 0; k < 6; ++k) { f32x4 v; v[0] = bf_lo(t[k].x); v[1] = bf_hi(t[k].x); v[2] = bf_lo(t[k].y); v[3] = bf_hi(t[k].y);
            if (k == 1) { v[0] = __expf(v[0]); v[1] = __expf(v[1]); v[2] = __expf(v[2]); v[3] = __expf(v[3]); }
            *(LAS f32x4*)(lbase + ((c & 1) * 6 + k) * 16 * 64) = v; }
    };
    auto yflush = [&](int c) {
        LAS const float* yb = ybuf + (c & 1) * 4096 + lt * 16;
        const f32x4 a = *(LAS const f32x4*)yb, b2 = *(LAS const f32x4*)(yb + 4), c2 = *(LAS const f32x4*)(yb + 8), d = *(LAS const f32x4*)(yb + 12);
        const f32x4 s4 = (a + b2) + (c2 + d);
        ybase[(size_t)c * 16 * 512] = (s4[0] + s4[1]) + (s4[2] + s4[3]);
    };
    __syncthreads();
    if (!comp) stage(0);
    __syncthreads();
    constexpr int nch = 4096 / 16;
    for (int c = 0; c < nch; ++c) {
        if (!comp) {
            if (c + 1 < nch) stage(c + 1);
            if (c > 0) yflush(c - 1);
        } else {
            LAS const float* bb = buf + (c & 1) * 6 * 16 * 64;
            LAS float* yb = ybuf + (c & 1) * 4096 + lt;
            ScanOps oA, oB;
            scan_ldops(oA, bb, 0, q, i);
#pragma unroll
            for (int s = 0; s < 16; s += 2) {
                scan_ldops(oB, bb, s + 1, q, i);
                scan_step(S, oA, yb + s * 256);
                if (s + 2 < 16) scan_ldops(oA, bb, s + 2, q, i);
                scan_step(S, oB, yb + (s + 1) * 256);
            }
        }
        __syncthreads();
    }
    if (!comp) yflush(nch - 1);
    if (comp) *(f32x4*)(p.out + O_PRWKV + (size_t)bh * 4096 + i * 64 + q * 4) = S;
}

__device__ __forceinline__ void scan_sample4(CParams& p, LAS unsigned char* lds, int item) {
    unsigned char* ws = p.ws;
    const int tid = opaque_tid(), il = tid >> 4, q = tid & 15;
    LAS float* buf = (LAS float*)lds;
    const int bh0 = item * 2;
    f32x4 S[4];
#pragma unroll
    for (int u = 0; u < 4; ++u) S[u] = *(const f32x4*)(p.in[5] + (size_t)(bh0 + (u >> 1)) * 4096 + ((u & 1) * 32 + il) * 64 + q * 4);
    __syncthreads();
#pragma unroll
    for (int k = 0; k < 3; ++k) {
        const int idx = tid + 512 * k; const int stt = idx / 768, rem = idx - stt * 768, ar = rem >> 7, st = (rem >> 4) & 7, f4 = rem & 15;
        const int bh = bh0 + stt, seq = bh >> 3, h = bh & 7;
        f32x4 vv = ld_bf4((const bf16_t*)(ws + W_R + (size_t)ar * RW_SZ) + (size_t)(NPT + seq * 8 + st) * 512 + h * 64 + f4 * 4);
        if (ar == 1) { vv[0] = __expf(vv[0]); vv[1] = __expf(vv[1]); vv[2] = __expf(vv[2]); vv[3] = __expf(vv[3]); }
        *(LAS f32x4*)(buf + ((stt * 6 + ar) * 8 + st) * 64 + f4 * 4) = vv;
    }
    __syncthreads();
#pragma unroll
    for (int s = 0; s < 8; ++s) {
#pragma unroll
        for (int u = 0; u < 4; ++u) {
            LAS const float* bb = buf + (u >> 1) * 6 * 8 * 64; const int i = (u & 1) * 32 + il;
            const f32x4 rv = *(LAS const f32x4*)(bb + (0 * 8 + s) * 64 + q * 4), dv = *(LAS const f32x4*)(bb + (1 * 8 + s) * 64 + q * 4), kv = *(LAS const f32x4*)(bb + (2 * 8 + s) * 64 + q * 4);
            const float vi = bb[(3 * 8 + s) * 64 + i];
            const f32x4 av = *(LAS const f32x4*)(bb + (4 * 8 + s) * 64 + q * 4), bv = *(LAS const f32x4*)(bb + (5 * 8 + s) * 64 + q * 4);
            const f32x4 sa4 = S[u] * av; const f32x4 tt = S[u] * dv + kv * vi;
            const float sa = allreduce16((sa4[0] + sa4[1]) + (sa4[2] + sa4[3]));
            S[u] = bv * sa + tt;
            const f32x4 y4 = S[u] * rv;
            const float y = allreduce16((y4[0] + y4[1]) + (y4[2] + y4[3]));
            const int bh = bh0 + (u >> 1);
            if (q == 0) ((float*)(ws + W_YRAW))[(size_t)(NPT + (bh >> 3) * 8 + s) * 512 + (bh & 7) * 64 + i] = y;
        }
    }
#pragma unroll
    for (int u = 0; u < 4; ++u) *(f32x4*)(p.out + O_SRWKV + (size_t)(bh0 + (u >> 1)) * 4096 + ((u & 1) * 32 + il) * 64 + q * 4) = S[u];
}

constexpr int CO_A1 = 0, CO_NM = 4608, CO_A3 = 6144, CO_BT = 8704, CO_KT = 11776, CO_VT = 14848, CO_GC = 17920, C_OP = 18432;
constexpr int CS_RAW = 2 * C_OP, CS_L = CS_RAW + 24576, CS_HAT = CS_L + 4352, CS_MAT = CS_HAT + 16384;
__device__ __forceinline__ bf16x8 frag_perm(const LAS bf16_t* M, int pitch, int row, int kb, int s2, int h) {
    const LAS bf16_t* q = M + row * pitch + kb + 16 * s2 + 4 * h;
    const u32x2 a = *(const LAS u32x2*)q, b = *(const LAS u32x2*)(q + 8);
    return __builtin_bit_cast(bf16x8, (u32x4){a.x, a.y, b.x, b.y});
}
__device__ __forceinline__ bf16x8 acc_frag(const f32x16& x, int s2) {
    return pack8(x[8 * s2 + 0], x[8 * s2 + 1], x[8 * s2 + 2], x[8 * s2 + 3], x[8 * s2 + 4], x[8 * s2 + 5], x[8 * s2 + 6], x[8 * s2 + 7]);
}
constexpr int PS_RAW = 0, PS_L = 24576, PS_HAT = PS_L + 4352, PS_MAT = PS_HAT + 16384, PS_OUT = PS_MAT + 5120, PS_SZ = PS_OUT + C_OP;
__device__ __forceinline__ void chunk_ops_phase(LAS unsigned char* lds_all, int bid, int nb) {
    CParams& p = kparams();
    unsigned char* ws = p.ws;
    const int tid = opaque_tid(); const int grp = tid >> 8, hid = tid & 255;
    LAS unsigned char* lds = lds_all + grp * PS_SZ;
    LAS float* RAW = (LAS float*)(lds + PS_RAW); LAS float* LP = (LAS float*)(lds + PS_L); LAS float* HAT = (LAS float*)(lds + PS_HAT); LAS float* MAT = (LAS float*)(lds + PS_MAT);
    LAS unsigned char* ob = lds + PS_OUT;
    const int npair = 4096;
    u32x4 pre[3];
    auto gl = [&](int pair) {
        const int gc = pair * 2 + grp; const int bh = gc >> 8, c = gc & 255; const int m0 = (bh >> 3) * 4096 + c * 16, hd = bh & 7;
#pragma unroll
        for (int k = 0; k < 3; ++k) { const int idx = hid + 256 * k; const int arr = idx >> 7, rem = idx & 127, t = rem >> 3, g8 = rem & 7;
            pre[k] = *(const u32x4*)((const bf16_t*)(ws + W_R + (size_t)arr * RW_SZ) + (size_t)(m0 + t) * 512 + hd * 64 + g8 * 8); }
    };
    int pair = bid;
    if (pair < npair) gl(pair);
    for (; pair < npair; pair += nb) {
        const int gc = pair * 2 + grp;
        {
#pragma unroll
            for (int k = 0; k < 3; ++k) { const int idx = hid + 256 * k; const int arr = idx >> 7, rem = idx & 127, t = rem >> 3, g8 = rem & 7;
                LAS float* d = RAW + (arr * 16 + t) * 64 + g8 * 8; const u32x4 v = pre[k];
                *(LAS f32x4*)d = (f32x4){bf_lo(v.x), bf_hi(v.x), bf_lo(v.y), bf_hi(v.y)}; *(LAS f32x4*)(d + 4) = (f32x4){bf_lo(v.z), bf_hi(v.z), bf_lo(v.w), bf_hi(v.w)}; }
            if (pair + nb < npair) gl(pair + nb);
        }
        __syncthreads();
        {
            float Lc[17]; { const int j = hid & 63; float acc = 0.f; Lc[0] = 0.f;
#pragma unroll
                for (int t = 0; t < 16; ++t) { acc += RAW[(1 * 16 + t) * 64 + j]; Lc[t + 1] = acc; } }
#pragma unroll
            for (int k = 0; k < 4; ++k) { const int e = hid + 256 * k; const int j = e & 63; const int tq = hid >> 6;
                float Lt = 0.f, Lp = 0.f;
#pragma unroll
                for (int t2 = 0; t2 < 16; ++t2) { if ((t2 & 3) == 0) {} if (t2 == tq + 4 * k) { Lt = Lc[t2 + 1]; Lp = Lc[t2]; } }
                const int t = tq + 4 * k; const float LC = Lc[16];
                const float rr = RAW[(0 * 16 + t) * 64 + j], kk = RAW[(2 * 16 + t) * 64 + j], vv = RAW[(3 * 16 + t) * 64 + j], aa = RAW[(4 * 16 + t) * 64 + j], bb = RAW[(5 * 16 + t) * 64 + j];
                const float Lm = Lc[8];
                const float ah = aa * __expf(Lp), rh = rr * __expf(Lt), en = __expf(Lm - Lt), em = __expf(-Lm), es = __expf(LC - Lt);
                LAS bf16_t* HH = (LAS bf16_t*)HAT;
                HH[t * 72 + j] = f2bf(ah * em); HH[(16 + t) * 72 + j] = f2bf(rh * em); HH[(32 + t) * 72 + j] = f2bf(bb * en); HH[(48 + t) * 72 + j] = f2bf(kk * en);
                ((LAS bf16_t*)(ob + CO_A1))[t * 72 + j] = f2bf(ah); ((LAS bf16_t*)(ob + CO_A1))[(16 + t) * 72 + j] = f2bf(rh);
                ((LAS bf16_t*)(ob + CO_BT))[j * 24 + t] = f2bf(bb * es); ((LAS bf16_t*)(ob + CO_KT))[j * 24 + t] = f2bf(kk * es); ((LAS bf16_t*)(ob + CO_VT))[j * 24 + t] = f2bf(vv);
                if (t == 15) ((LAS float*)(ob + CO_GC))[j] = __expf(LC); }
        }
        __syncthreads();
        if (hid < 64) {
            LAS const bf16_t* HH = (LAS const bf16_t*)HAT; const int r = hid & 31, h = hid >> 5;
            f32x16 D;
#pragma unroll
            for (int i2 = 0; i2 < 16; ++i2) D[i2] = 0.f;
#pragma unroll
            for (int ks = 0; ks < 4; ++ks) D = mfma32(*(const LAS bf16x8*)(HH + (32 + r) * 72 + ks * 16 + h * 8), *(const LAS bf16x8*)(HH + r * 72 + ks * 16 + h * 8), D);
            const int y = r;
#pragma unroll
            for (int reg = 0; reg < 16; ++reg) { const int x = (reg & 3) + 8 * (reg >> 2) + 4 * h;
                const int mat = (x >> 4) + 2 * (y >> 4), xx = x & 15, yy = y & 15;
                const bool nz = (y < 16) ? (xx < yy) : (xx <= yy);
                MAT[mat * 256 + xx * 16 + yy] = nz ? D[reg] : 0.f; }
        }
        __syncthreads();
        if (hid < 16) {
            const int tau = hid; float T[16];
#pragma unroll
            for (int s = 0; s < 16; ++s) { float v = (s == tau) ? 1.f : 0.f;
#pragma unroll
                for (int sg = 0; sg < s; ++sg) v += (sg >= tau) ? T[sg] * MAT[0 * 256 + sg * 16 + s] : 0.f;
                T[s] = v; }
#pragma unroll
            for (int s = 0; s < 16; ++s) MAT[4 * 256 + tau * 16 + s] = T[s];
        }
        __syncthreads();
        {
            LAS const float* TT = MAT + 4 * 256;
#pragma unroll
            for (int k = 0; k < 4; ++k) { const int e = hid + 256 * k; const int row = e >> 5, col = e & 31; float v;
                if (row < 16) v = (col < 16) ? TT[col * 16 + row] : 0.f;
                else { const int t = row - 16;
                    if (col < 16) { v = 0.f;
#pragma unroll
                        for (int s = 0; s < 16; ++s) v += MAT[2 * 256 + s * 16 + t] * TT[col * 16 + s]; }
                    else v = (col - 16 == t) ? 1.f : 0.f; }
                ((LAS bf16_t*)(ob + CO_A3))[row * 40 + col] = f2bf(v); }
#pragma unroll
            for (int k = 0; k < 2; ++k) { const int e = hid + 256 * k; const int row = e >> 4, col = e & 15;
                const float v = (row < 16) ? MAT[1 * 256 + col * 16 + row] : MAT[3 * 256 + col * 16 + (row - 16)];
                ((LAS bf16_t*)(ob + CO_NM))[row * 24 + col] = f2bf(v); }
        }
        __syncthreads();
        {
            unsigned char* dst = ws + W_COP + (size_t)gc * C_OP;
            for (int e = hid; e < C_OP / 16; e += 256) *(u32x4*)(dst + e * 16) = *(LAS const u32x4*)(ob + e * 16);
        }
    }
}

__device__ __forceinline__ void scan_chain(CParams& p, LAS unsigned char* lds, int bh) {
    unsigned char* ws = p.ws;
    const int tid = opaque_tid(), wv = __builtin_amdgcn_readfirstlane(tid >> 6), lane = tid & 63, r = lane & 31, h = lane >> 5;
    const int b = bh >> 3, hd = bh & 7, m0 = b * 4096;
    const bool comp = wv < 2; const int it = wv;
    const int hid = tid - 128;
    const unsigned char* cop = ws + W_COP + (size_t)bh * 256 * C_OP;
    f32x16 X0, X1;
#pragma unroll
    for (int i2 = 0; i2 < 16; ++i2) { X0[i2] = 0.f; X1[i2] = 0.f; }
    constexpr int nch = 256;
    u32x4 cp[3];
    auto cload = [&](int c) {
#pragma unroll
        for (int k = 0; k < 3; ++k) cp[k] = *(const u32x4*)(cop + (size_t)c * C_OP + (hid + 384 * k) * 16); };
    auto cstore = [&](int c) {
#pragma unroll
        for (int k = 0; k < 3; ++k) *(LAS u32x4*)(lds + (c & 1) * C_OP + (hid + 384 * k) * 16) = cp[k]; };
    __syncthreads();
    if (!comp) { cload(0); cstore(0); cload(1); }
    __syncthreads();
    for (int c = 0; c < nch; ++c) {
        if (!comp) { if (c + 1 < nch) { cstore(c + 1); if (c + 2 < nch) cload(c + 2); } }
        else {
            LAS const bf16_t* A1 = (LAS const bf16_t*)(lds + (c & 1) * C_OP + CO_A1); LAS const bf16_t* NM = (LAS const bf16_t*)(lds + (c & 1) * C_OP + CO_NM);
            LAS const bf16_t* A3 = (LAS const bf16_t*)(lds + (c & 1) * C_OP + CO_A3); LAS const bf16_t* BT = (LAS const bf16_t*)(lds + (c & 1) * C_OP + CO_BT);
            LAS const bf16_t* KT = (LAS const bf16_t*)(lds + (c & 1) * C_OP + CO_KT); LAS const bf16_t* VT = (LAS const bf16_t*)(lds + (c & 1) * C_OP + CO_VT);
            LAS const float* GC = (LAS const float*)(lds + (c & 1) * C_OP + CO_GC);
            const bf16x8 vfr = *(const LAS bf16x8*)(VT + (32 * it + r) * 24 + 8 * h);
            f32x16 Q;
#pragma unroll
            for (int i2 = 0; i2 < 16; ++i2) Q[i2] = 0.f;
#pragma unroll
            for (int s2 = 0; s2 < 2; ++s2) { Q = mfma32(frag_perm(A1, 72, r, 0, s2, h), acc_frag(X0, s2), Q); Q = mfma32(frag_perm(A1, 72, r, 32, s2, h), acc_frag(X1, s2), Q); }
            Q = mfma32(*(const LAS bf16x8*)(NM + r * 24 + 8 * h), vfr, Q);
            f32x16 G;
#pragma unroll
            for (int i2 = 0; i2 < 16; ++i2) G[i2] = 0.f;
#pragma unroll
            for (int s2 = 0; s2 < 2; ++s2) G = mfma32(frag_perm(A3, 40, r, 0, s2, h), acc_frag(Q, s2), G);
            float* yo = (float*)(ws + W_YRAW) + (size_t)(m0 + c * 16) * 512 + hd * 64 + 32 * it + r;
#pragma unroll
            for (int reg = 8; reg < 16; ++reg) { const int t = (reg & 3) + 8 * ((reg >> 2) - 2) + 4 * h; yo[(size_t)t * 512] = G[reg]; }
            const bf16x8 ufr = acc_frag(G, 0);
#pragma unroll
            for (int jt = 0; jt < 2; ++jt) {
                f32x16 Xn = jt == 0 ? X0 : X1;
#pragma unroll
                for (int q4 = 0; q4 < 4; ++q4) { const f32x4 gc = *(const LAS f32x4*)(GC + 32 * jt + 8 * q4 + 4 * h);
#pragma unroll
                    for (int e = 0; e < 4; ++e) Xn[4 * q4 + e] *= gc[e]; }
                Xn = mfma32(frag_perm(BT, 24, 32 * jt + r, 0, 0, h), ufr, Xn);
                Xn = mfma32(*(const LAS bf16x8*)(KT + (32 * jt + r) * 24 + 8 * h), vfr, Xn);
                if (jt == 0) X0 = Xn; else X1 = Xn;
            }
        }
        __syncthreads();
    }
    if (comp) {
        float* so = p.out + O_PRWKV + (size_t)bh * 4096 + (size_t)(32 * it + r) * 64;
#pragma unroll
        for (int jt = 0; jt < 2; ++jt)
#pragma unroll
            for (int q4 = 0; q4 < 4; ++q4) { const f32x16& Xs = jt == 0 ? X0 : X1;
                *(f32x4*)(so + 32 * jt + 8 * q4 + 4 * h) = (f32x4){Xs[4 * q4], Xs[4 * q4 + 1], Xs[4 * q4 + 2], Xs[4 * q4 + 3]}; }
    }
}

constexpr int A_KL = 0, A_VL = 9216, A_KV1 = 17920  , A_G = 35840, A_E = A_G + 16384, A_MISC = A_E + 16384, A_FIN = A_MISC + 512;
struct AttnSt { f32x16 o0, o1; float m, l; };
__device__ __forceinline__ void attn_init(AttnSt& s) {
#pragma unroll
    for (int i = 0; i < 16; ++i) { s.o0[i] = 0.f; s.o1[i] = 0.f; }
    s.m = -1e30f; s.l = 0.f;
}
__device__ __forceinline__ int keyl_of(int reg, int h) { return (reg & 3) + 8 * (reg >> 2) + 4 * h; }
__device__ __forceinline__ unsigned range_mask(int base, int h, int lo, int hi) {
    unsigned vm = 0;
#pragma unroll
    for (int reg = 0; reg < 16; ++reg) { const int k = base + keyl_of(reg, h); vm |= (k >= lo && k <= hi) ? (1u << reg) : 0u; }
    return vm;
}
__device__ __forceinline__ f32x16 qk_sub(const LAS bf16_t* Kl, int krow0, const bf16x8 (&Qf)[4], int r, int h) {
    f32x16 s;
#pragma unroll
    for (int i = 0; i < 16; ++i) s[i] = 0.f;
#pragma unroll
    for (int ks = 0; ks < 4; ++ks) { const bf16x8 kf = *(const LAS bf16x8*)(Kl + (krow0 + r) * 72 + ks * 16 + h * 8); s = mfma32(kf, Qf[ks], s); }
    return s;
}
__device__ __forceinline__ void sm_update(f32x16& s, AttnSt& st, unsigned vm) {
    const bool full = (__ballot(vm != 0xffffu) == 0ull);
    float mx = -1e30f;
    if (full) {
#pragma unroll
        for (int reg = 0; reg < 16; ++reg) mx = fmaxf(mx, s[reg]);
    } else {
#pragma unroll
        for (int reg = 0; reg < 16; ++reg) mx = ((vm >> reg) & 1u) ? fmaxf(mx, s[reg]) : mx;
    }
    mx = fmaxf(mx, __shfl_xor(mx, 32));
    if (__ballot(mx > st.m + 8.0f) != 0ull) {
        const float mnew = fmaxf(st.m, mx); const float alpha = __builtin_amdgcn_exp2f(st.m - mnew);
        st.l *= alpha; st.m = mnew; st.o0 = st.o0 * alpha; st.o1 = st.o1 * alpha;
    }
    float sum = 0.f; const float mref = st.m;
    if (full) {
#pragma unroll
        for (int reg = 0; reg < 16; ++reg) { const float pv = __builtin_amdgcn_exp2f(s[reg] - mref); s[reg] = pv; sum += pv; }
    } else {
#pragma unroll
        for (int reg = 0; reg < 16; ++reg) { const float pv = ((vm >> reg) & 1u) ? __builtin_amdgcn_exp2f(s[reg] - mref) : 0.f; s[reg] = pv; sum += pv; }
    }
    st.l += sum;
}
__device__ __forceinline__ void pv_sub(const LAS bf16_t* Vl, int kcol0, const f32x16& pr, AttnSt& st, int r, int h) {
#pragma unroll
    for (int s2 = 0; s2 < 2; ++s2) {
        const bf16x8 pf = pack8(pr[8 * s2 + 0], pr[8 * s2 + 1], pr[8 * s2 + 2], pr[8 * s2 + 3], pr[8 * s2 + 4], pr[8 * s2 + 5], pr[8 * s2 + 6], pr[8 * s2 + 7]);
#pragma unroll
        for (int dt = 0; dt < 2; ++dt) {
            const LAS bf16_t* vp = Vl + (dt * 32 + r) * 68 + kcol0 + 16 * s2 + 4 * h;
            const u32x2 a = *(const LAS u32x2*)vp, b = *(const LAS u32x2*)(vp + 8);
            const bf16x8 vf = __builtin_bit_cast(bf16x8, (u32x4){a.x, a.y, b.x, b.y});
            if (dt == 0) st.o0 = mfma32(vf, pf, st.o0); else st.o1 = mfma32(vf, pf, st.o1);
        }
    }
}
__device__ __forceinline__ float xhalf_max(float x) {
    const auto r2 = __builtin_amdgcn_permlane32_swap(__float_as_uint(x), __float_as_uint(x), false, false);
    return fmaxf(__uint_as_float(r2[0]), __uint_as_float(r2[1]));
}
__device__ __forceinline__ void qk_tile(const LAS bf16_t* Kl, const bf16x8 (&Qf)[4], int r, int h, f32x16& s0, f32x16& s1) {
#pragma unroll
    for (int i = 0; i < 16; ++i) { s0[i] = 0.f; s1[i] = 0.f; }
#pragma unroll
    for (int ks = 0; ks < 4; ++ks) {
        const bf16x8 k0 = *(const LAS bf16x8*)(Kl + r * 72 + ks * 16 + h * 8), k1 = *(const LAS bf16x8*)(Kl + (32 + r) * 72 + ks * 16 + h * 8);
        s0 = mfma32(k0, Qf[ks], s0); s1 = mfma32(k1, Qf[ks], s1);
    }
}
__device__ __forceinline__ void sm_update2(f32x16& s0, f32x16& s1, AttnSt& st, unsigned vm0, unsigned vm1) {
    const bool full = (__ballot((vm0 & vm1) != 0xffffu) == 0ull);
    float mx = -1e30f;
    if (full) {
#pragma unroll
        for (int reg = 0; reg < 16; ++reg) mx = fmaxf(mx, fmaxf(s0[reg], s1[reg]));
    } else {
#pragma unroll
        for (int reg = 0; reg < 16; ++reg) { mx = ((vm0 >> reg) & 1u) ? fmaxf(mx, s0[reg]) : mx; mx = ((vm1 >> reg) & 1u) ? fmaxf(mx, s1[reg]) : mx; }
    }
    mx = xhalf_max(mx);
    if (__ballot(mx > st.m + 8.0f) != 0ull) {
        const float mnew = fmaxf(st.m, mx); const float alpha = __builtin_amdgcn_exp2f(st.m - mnew);
        st.l *= alpha; st.m = mnew; st.o0 = st.o0 * alpha; st.o1 = st.o1 * alpha;
    }
    float sum = 0.f; const float mref = st.m;
    if (full) {
#pragma unroll
        for (int reg = 0; reg < 16; ++reg) { const float p0 = __builtin_amdgcn_exp2f(s0[reg] - mref), p1 = __builtin_amdgcn_exp2f(s1[reg] - mref); s0[reg] = p0; s1[reg] = p1; sum += p0 + p1; }
    } else {
#pragma unroll
        for (int reg = 0; reg < 16; ++reg) {
            const float p0 = ((vm0 >> reg) & 1u) ? __builtin_amdgcn_exp2f(s0[reg] - mref) : 0.f, p1 = ((vm1 >> reg) & 1u) ? __builtin_amdgcn_exp2f(s1[reg] - mref) : 0.f;
            s0[reg] = p0; s1[reg] = p1; sum += p0 + p1; }
    }
    st.l += sum;
}
__device__ __forceinline__ void attn_tile(const LAS bf16_t* Kl, const LAS bf16_t* Vl, const bf16x8 (&Qf)[4], AttnSt& st, unsigned vm0, unsigned vm1, int r, int h) {
    if (__ballot((vm0 | vm1) != 0u) == 0ull) return;
    f32x16 s0, s1;
    qk_tile(Kl, Qf, r, h, s0, s1);
    sm_update2(s0, s1, st, vm0, vm1);
    pv_sub(Vl, 0, s0, st, r, h); pv_sub(Vl, 32, s1, st, r, h);
}
struct StgB { u32x4 k, v; };
__device__ __forceinline__ void ldg_k(StgB& s, const bf16_t* Kg, int tid) { s.k = *(const u32x4*)(Kg + (tid >> 3) * 64 + (tid & 7) * 8); }
__device__ __forceinline__ void ldg_vt(StgB& s, const bf16_t* Vg, int Tp, int tid) { s.v = *(const u32x4*)(Vg + (size_t)(tid >> 3) * Tp + (tid & 7) * 8); }
__device__ __forceinline__ void sts_k(LAS bf16_t* Kl, const StgB& s, int tid) { *(LAS u32x4*)(Kl + (tid >> 3) * 72 + (tid & 7) * 8) = s.k; }
__device__ __forceinline__ void sts_vt(LAS bf16_t* Vl, const StgB& s, int tid) { LAS u32x2* d = (LAS u32x2*)(Vl + (tid >> 3) * 68 + (tid & 7) * 8); d[0] = (u32x2){s.v.x, s.v.y}; d[1] = (u32x2){s.v.z, s.v.w}; }
struct StgF { f32x4 k0, k1, v0, v1; };
__device__ __forceinline__ void ldg_f32(StgF& s, const float* rowp, int g, int tid) {
    const f32x4 z = (f32x4){0.f, 0.f, 0.f, 0.f}; s.k0 = z; s.k1 = z; s.v0 = z; s.v1 = z;
    if (rowp) { const float* q = rowp + g * 64 + (tid & 7) * 8; s.k0 = *(const f32x4*)q; s.k1 = *(const f32x4*)(q + 4); s.v0 = *(const f32x4*)(q + 128); s.v1 = *(const f32x4*)(q + 132); }
}
__device__ __forceinline__ void sts_f32(LAS bf16_t* Kl, LAS bf16_t* Vl, const StgF& s, int tid) {
    const int key = tid >> 3, part = tid & 7;
    u32x4 w; w.x = cvt_pk_bf16(s.k0[0], s.k0[1]); w.y = cvt_pk_bf16(s.k0[2], s.k0[3]); w.z = cvt_pk_bf16(s.k1[0], s.k1[1]); w.w = cvt_pk_bf16(s.k1[2], s.k1[3]);
    *(LAS u32x4*)(Kl + key * 72 + part * 8) = w;
#pragma unroll
    for (int j = 0; j < 4; ++j) { Vl[(part * 8 + j) * 68 + key] = f2bf(s.v0[j]); Vl[(part * 8 + 4 + j) * 68 + key] = f2bf(s.v1[j]); }
}
__device__ __forceinline__ void cmp_stats(const f32x16& s, unsigned vm, float& m1, float& l1) {
    float mx = -1e30f;
#pragma unroll
    for (int reg = 0; reg < 16; ++reg) mx = ((vm >> reg) & 1u) ? fmaxf(mx, s[reg]) : mx;
    mx = fmaxf(mx, __shfl_xor(mx, 32));
    const float mnew = fmaxf(m1, mx); float sum = 0.f;
#pragma unroll
    for (int reg = 0; reg < 16; ++reg) sum += ((vm >> reg) & 1u) ? __builtin_amdgcn_exp2f(s[reg] - mnew) : 0.f;
    l1 = l1 * __builtin_amdgcn_exp2f(m1 - mnew) + sum; m1 = mnew;
}
__device__ __forceinline__ void cmp_probs(f32x16& s, unsigned vm, float m1, float inv, LAS float* Gl, LAS float* El, int tlrow, int jbase, int r, int h) {
#pragma unroll
    for (int reg = 0; reg < 16; ++reg) s[reg] = ((vm >> reg) & 1u) ? __builtin_amdgcn_exp2f(s[reg] - m1) * inv : 0.f;
#pragma unroll
    for (int q4 = 0; q4 < 4; ++q4) {
        const float p0 = allreduce4(s[4 * q4]), p1 = allreduce4(s[4 * q4 + 1]), p2 = allreduce4(s[4 * q4 + 2]), p3 = allreduce4(s[4 * q4 + 3]);
        if ((r & 3) == 0) { const int j = jbase + 2 * q4 + h; Gl[tlrow * 64 + j] = (p0 + p1) + (p2 + p3); El[tlrow * 64 + j] = p3; }
    }
}
__device__ __forceinline__ unsigned long long topk_mask(const LAS float* Gl, const LAS float* El, int tlrow, int cur, int lane) {
    if (cur < 16) return (1ull << (cur + 1)) - 1ull;
    const int j = lane;
    const float imp = Gl[tlrow * 64 + j] + (j > 0 ? El[tlrow * 64 + j - 1] : 0.f);
    int rank = 0;
    for (int jp = 1; jp <= cur - 2; ++jp) { const float v = __int_as_float(__builtin_amdgcn_readlane(__float_as_int(imp), jp)); rank += ((v > imp) || (v == imp && jp < j)) ? 1 : 0; }
    const bool sel = (j >= 1 && j <= cur - 2 && rank < 13) || j == 0 || j == cur || j == cur - 1;
    return __ballot(sel);
}
__device__ __forceinline__ void attn_fold(LAS float* fin, int tid, AttnSt& st, float gate, bool normalised, int mode) {
    float sc = gate;
    if (!normalised) { const float lt = st.l + __shfl_xor(st.l, 32); sc = lt > 0.f ? gate / lt : 0.f; }
#pragma unroll
    for (int reg = 0; reg < 16; ++reg) {
        float a = st.o0[reg] * sc, b = st.o1[reg] * sc;
        if (mode != 0) { a += fin[reg * 512 + tid]; b += fin[(16 + reg) * 512 + tid]; }
        if (mode == 2) { st.o0[reg] = a; st.o1[reg] = b; } else { fin[reg * 512 + tid] = a; fin[(16 + reg) * 512 + tid] = b; }
    }
}
__device__ __forceinline__ void attn_store(CParams& p, int m, int head, const f32x16& f0, const f32x16& f1, int h) {
    bf16_t* yo = (bf16_t*)(p.ws + W_YCAT) + (size_t)m * 1024 + 512 + head * 64;
#pragma unroll
    for (int dt = 0; dt < 2; ++dt)
#pragma unroll
        for (int q4 = 0; q4 < 4; ++q4) {
            f32x4 v;
#pragma unroll
            for (int j = 0; j < 4; ++j) { const int reg = 4 * q4 + j; v[j] = dt == 0 ? f0[reg] : f1[reg]; }
            *(u32x2*)(yo + dt * 32 + 8 * q4 + 4 * h) = pack4(v);
        }
}

__device__ __forceinline__ void attn_prompt_tile(CParams& p, LAS unsigned char* lds, int item) {
    unsigned char* ws = p.ws;
    const int tid = opaque_tid(), wv = __builtin_amdgcn_readfirstlane(tid >> 6), lane = tid & 63, r = lane & 31, h = lane >> 5;
    const int T = 63 - (item >> 3), bg = item & 7, b = bg >> 1, g = bg & 1;
    const int tl = wv * 8 + (r >> 2), head = g * 4 + (r & 3);
    const int pos = 64 * T + tl, m = b * 4096 + pos;
    LAS bf16_t* Kl = (LAS bf16_t*)(lds + A_KL); LAS bf16_t* Vl = (LAS bf16_t*)(lds + A_VL); LAS float* Gl = (LAS float*)(lds + A_G); LAS float* El = (LAS float*)(lds + A_E);
    __syncthreads();
    for (int i = tid; i < 8192; i += NTHR) Gl[i] = 0.f;
    bf16x8 Qf[4];
#pragma unroll
    for (int ks = 0; ks < 4; ++ks) Qf[ks] = *(const bf16x8*)((const bf16_t*)(ws + W_QC) + (size_t)m * 512 + head * 64 + ks * 16 + h * 8);
    const int climit = pos >= 31 ? ((pos - 31) >> 4) : -1;
    const int nct = (4 * T + 3 + 63) >> 6;
    const bf16_t* Kc = (const bf16_t*)(ws + W_KCP) + (size_t)bg * 256 * 64; const bf16_t* Vc = (const bf16_t*)(ws + W_VCPT) + (size_t)bg * 64 * 256;
    float m1 = -1e30f, l1 = 0.f;
    StgB sg;
    ldg_k(sg, Kc, tid);
    for (int tile = 0; tile < nct; ++tile) {
        __syncthreads(); sts_k(Kl, sg, tid); __syncthreads();
        if (tile + 1 < nct) ldg_k(sg, Kc + (size_t)(tile + 1) * 64 * 64, tid);
#pragma unroll
        for (int sub = 0; sub < 2; ++sub) { const f32x16 s = qk_sub(Kl, sub * 32, Qf, r, h); cmp_stats(s, range_mask(tile * 64 + sub * 32, h, 0, climit), m1, l1); }
    }
    const float l1t = l1 + __shfl_xor(l1, 32); const float inv1 = l1t > 0.f ? 1.0f / l1t : 0.f;
    const float* gn = (const float*)(ws + W_GN) + (size_t)m * 24 + head * 3;
    const float gt0 = gn[0], gt1 = gn[1], gt2 = gn[2];
    LAS float* fin = (LAS float*)(lds + A_FIN);
    AttnSt oc; attn_init(oc);
    ldg_k(sg, Kc, tid); ldg_vt(sg, Vc, 256, tid);
    for (int tile = 0; tile < nct; ++tile) {
        __syncthreads(); sts_k(Kl, sg, tid); sts_vt(Vl, sg, tid); __syncthreads();
        if (tile + 1 < nct) { ldg_k(sg, Kc + (size_t)(tile + 1) * 64 * 64, tid); ldg_vt(sg, Vc + (tile + 1) * 64, 256, tid); }
#pragma unroll
        for (int sub = 0; sub < 2; ++sub) {
            f32x16 s = qk_sub(Kl, sub * 32, Qf, r, h);
            cmp_probs(s, range_mask(tile * 64 + sub * 32, h, 0, climit), m1, inv1, Gl, El, tl, tile * 16 + sub * 8, r, h);
            pv_sub(Vl, sub * 32, s, oc, r, h);
        }
    }
    attn_fold(fin, tid, oc, gt0, true, 0);
    __syncthreads();
    unsigned long long mymask = 0ull, anymask = 0ull;
    for (int k = 0; k < 8; ++k) { const unsigned long long mk = topk_mask(Gl, El, wv * 8 + k, T, lane); anymask |= mk; if ((r >> 2) == k) mymask = mk; }
#pragma unroll
    for (int ks = 0; ks < 4; ++ks) Qf[ks] = *(const bf16x8*)((const bf16_t*)(ws + W_QR) + (size_t)m * 512 + head * 64 + ks * 16 + h * 8);
    attn_init(oc);
    {
        const bf16_t* Kg = (const bf16_t*)(ws + W_KS) + (size_t)bg * 4096 * 64; const bf16_t* Vg = (const bf16_t*)(ws + W_VST) + (size_t)bg * 64 * 4096;
        ldg_k(sg, Kg, tid); ldg_vt(sg, Vg, 4096, tid);
        __syncthreads(); sts_k(Kl, sg, tid); sts_vt(Vl, sg, tid);
        if (T >= 1) { ldg_k(sg, Kg + (size_t)64 * 64, tid); ldg_vt(sg, Vg + 64, 4096, tid); }
        for (int j = 0; j <= T; ++j) {
            LAS bf16_t* Kc_ = (LAS bf16_t*)(lds + (j & 1) * A_KV1); LAS bf16_t* Vc_ = Kc_ + 4608;
            LAS bf16_t* Kn_ = (LAS bf16_t*)(lds + ((j + 1) & 1) * A_KV1); LAS bf16_t* Vn_ = Kn_ + 4608;
            __syncthreads();
            if (j < T) { sts_k(Kn_, sg, tid); sts_vt(Vn_, sg, tid); }
            if (j + 1 < T) { ldg_k(sg, Kg + (size_t)(j + 2) * 64 * 64, tid); ldg_vt(sg, Vg + (j + 2) * 64, 4096, tid); }
            if ((anymask >> j) & 1ull) {
                const bool en = (mymask >> j) & 1ull;
                const unsigned vm0 = en ? (j < T ? 0xffffu : range_mask(j * 64, h, -1, pos)) : 0u, vm1 = en ? (j < T ? 0xffffu : range_mask(j * 64 + 32, h, -1, pos)) : 0u;
                attn_tile(Kc_, Vc_, Qf, oc, vm0, vm1, r, h);
            }
        }
    }
    attn_fold(fin, tid, oc, gt1, false, 1);
    attn_init(oc);
    {
        const bf16_t* Kg = (const bf16_t*)(ws + W_KW) + (size_t)bg * 4096 * 64; const bf16_t* Vg = (const bf16_t*)(ws + W_VWT) + (size_t)bg * 64 * 4096;
        const int j0 = (T > 8 ? T - 8 : 0);
        ldg_k(sg, Kg + (size_t)j0 * 64 * 64, tid); ldg_vt(sg, Vg + j0 * 64, 4096, tid);
        __syncthreads(); sts_k(Kl, sg, tid); sts_vt(Vl, sg, tid);
        if (j0 < T) { ldg_k(sg, Kg + (size_t)(j0 + 1) * 64 * 64, tid); ldg_vt(sg, Vg + (j0 + 1) * 64, 4096, tid); }
        for (int j = j0; j <= T; ++j) {
            const int pb = (j - j0) & 1;
            LAS bf16_t* Kc_ = (LAS bf16_t*)(lds + pb * A_KV1); LAS bf16_t* Vc_ = Kc_ + 4608;
            LAS bf16_t* Kn_ = (LAS bf16_t*)(lds + (pb ^ 1) * A_KV1); LAS bf16_t* Vn_ = Kn_ + 4608;
            __syncthreads();
            if (j < T) { sts_k(Kn_, sg, tid); sts_vt(Vn_, sg, tid); }
            if (j + 1 < T) { ldg_k(sg, Kg + (size_t)(j + 2) * 64 * 64, tid); ldg_vt(sg, Vg + (j + 2) * 64, 4096, tid); }
            const bool inner = (j > T - 8 && j < T);
            const unsigned vm0 = inner ? 0xffffu : range_mask(j * 64, h, pos - 511, pos), vm1 = inner ? 0xffffu : range_mask(j * 64 + 32, h, pos - 511, pos);
            attn_tile(Kc_, Vc_, Qf, oc, vm0, vm1, r, h);
        }
    }
    attn_fold(fin, tid, oc, gt2, false, 2);
    attn_store(p, m, head, oc.o0, oc.o1, h);
}

__device__ __forceinline__ void attn_sample_unit(CParams& p, LAS unsigned char* lds, int unit) {
    unsigned char* ws = p.ws;
    const int tid = opaque_tid(), wv = __builtin_amdgcn_readfirstlane(tid >> 6), lane = tid & 63, r = lane & 31, h = lane >> 5;
    const int seq = unit >> 1, g = unit & 1; const bool act = (wv == 0);
    const int tq = r >> 2, head = g * 4 + (r & 3), pos = 2048 + tq, m = NPT + seq * 8 + tq;
    LAS bf16_t* Kl = (LAS bf16_t*)(lds + A_KL); LAS bf16_t* Vl = (LAS bf16_t*)(lds + A_VL); LAS float* Gl = (LAS float*)(lds + A_G); LAS float* El = (LAS float*)(lds + A_E);
    LAS unsigned* misc = (LAS unsigned*)(lds + A_MISC);
    __syncthreads();
    for (int i = tid; i < 8192; i += NTHR) Gl[i] = 0.f;
    bf16x8 Qf[4];
#pragma unroll
    for (int ks = 0; ks < 4; ++ks) Qf[ks] = *(const bf16x8*)((const bf16_t*)(ws + W_QC) + (size_t)m * 512 + head * 64 + ks * 16 + h * 8);
    const bf16_t* Kc = (const bf16_t*)(ws + W_KCS) + (size_t)unit * 128 * 64; const bf16_t* Vc = (const bf16_t*)(ws + W_VCST) + (size_t)unit * 64 * 128;
    float m1 = -1e30f, l1 = 0.f;
    StgB sg;
    for (int tile = 0; tile < 2; ++tile) {
        ldg_k(sg, Kc + (size_t)tile * 64 * 64, tid);
        __syncthreads(); sts_k(Kl, sg, tid); __syncthreads();
        if (act) {
#pragma unroll
            for (int sub = 0; sub < 2; ++sub) { const f32x16 s = qk_sub(Kl, sub * 32, Qf, r, h); cmp_stats(s, range_mask(tile * 64 + sub * 32, h, 0, 126), m1, l1); }
        }
    }
    const float l1t = l1 + __shfl_xor(l1, 32); const float inv1 = l1t > 0.f ? 1.0f / l1t : 0.f;
    const float* gn = (const float*)(ws + W_GN) + (size_t)m * 24 + head * 3;
    const float gt0 = gn[0], gt1 = gn[1], gt2 = gn[2];
    LAS float* fin = (LAS float*)(lds + A_FIN);
    AttnSt oc; attn_init(oc);
    for (int tile = 0; tile < 2; ++tile) {
        ldg_k(sg, Kc + (size_t)tile * 64 * 64, tid); ldg_vt(sg, Vc + tile * 64, 128, tid);
        __syncthreads(); sts_k(Kl, sg, tid); sts_vt(Vl, sg, tid); __syncthreads();
        if (act) {
#pragma unroll
            for (int sub = 0; sub < 2; ++sub) {
                f32x16 s = qk_sub(Kl, sub * 32, Qf, r, h);
                cmp_probs(s, range_mask(tile * 64 + sub * 32, h, 0, 126), m1, inv1, Gl, El, tq, tile * 16 + sub * 8, r, h);
                pv_sub(Vl, sub * 32, s, oc, r, h);
            }
        }
    }
    __syncthreads();
    if (act) {
        unsigned long long anym = 0ull;
        for (int k = 0; k < 8; ++k) { const unsigned long long mk = topk_mask(Gl, El, k, 32, lane); anym |= mk; if (lane == 0) { misc[2 * k] = (unsigned)mk; misc[2 * k + 1] = (unsigned)(mk >> 32); } }
        if (lane == 0) { misc[16] = (unsigned)anym; misc[17] = (unsigned)(anym >> 32); }
    }
    __syncthreads();
    const unsigned long long anymask = (unsigned long long)misc[16] | ((unsigned long long)misc[17] << 32);
    const unsigned long long mymask = (unsigned long long)misc[2 * tq] | ((unsigned long long)misc[2 * tq + 1] << 32);
#pragma unroll
    for (int ks = 0; ks < 4; ++ks) Qf[ks] = *(const bf16x8*)((const bf16_t*)(ws + W_QR) + (size_t)m * 512 + head * 64 + ks * 16 + h * 8);
    const int* pt = (const int*)p.in[7] + seq * 16;
    __syncthreads();
    LAS bf16_t* Kw = (LAS bf16_t*)(lds + wv * 17920); LAS bf16_t* Vw = Kw + 4608;
    AttnSt os, ow; attn_init(os); attn_init(ow);
    auto slc_row = [&](int j, int key) -> const float* {
        if (j < 32) return p.in[3] + ((size_t)pt[j >> 1] * 128 + (j & 1) * 64 + key) * 256;
        return key < 8 ? p.out + O_SSLC + ((size_t)seq * 8 + key) * 256 : nullptr;
    };
    auto win_row = [&](int wt, int key) -> const float* {
        const int idx = wt * 64 + key;
        return idx < 512 ? p.in[4] + ((size_t)seq * 512 + idx) * 256 : (idx < 520 ? p.out + O_SWIN + ((size_t)seq * 512 + 504 + (idx - 512)) * 256 : nullptr);
    };
    auto stage_tile = [&](bool is_win, int tix) {
        f32x4 kr[2][4], vr[2][4];
        auto ld = [&](int pass, int bufi) {
            const int key = pass * 16 + (lane >> 2); const float* rp = is_win ? win_row(tix, key) : slc_row(tix, key);
#pragma unroll
            for (int u = 0; u < 4; ++u) { kr[bufi][u] = (f32x4){0.f, 0.f, 0.f, 0.f}; vr[bufi][u] = kr[bufi][u]; }
            if (rp) { const float* q0 = rp + g * 64 + (lane & 3) * 16;
#pragma unroll
                for (int u = 0; u < 4; ++u) { kr[bufi][u] = *(const f32x4*)(q0 + u * 4); vr[bufi][u] = *(const f32x4*)(q0 + 128 + u * 4); } }
        };
        auto st = [&](int pass, int bufi) {
            const int key = pass * 16 + (lane >> 2), d0 = (lane & 3) * 16;
            u32x4 w0, w1;
            w0.x = cvt_pk_bf16(kr[bufi][0][0], kr[bufi][0][1]); w0.y = cvt_pk_bf16(kr[bufi][0][2], kr[bufi][0][3]); w0.z = cvt_pk_bf16(kr[bufi][1][0], kr[bufi][1][1]); w0.w = cvt_pk_bf16(kr[bufi][1][2], kr[bufi][1][3]);
            w1.x = cvt_pk_bf16(kr[bufi][2][0], kr[bufi][2][1]); w1.y = cvt_pk_bf16(kr[bufi][2][2], kr[bufi][2][3]); w1.z = cvt_pk_bf16(kr[bufi][3][0], kr[bufi][3][1]); w1.w = cvt_pk_bf16(kr[bufi][3][2], kr[bufi][3][3]);
            *(LAS u32x4*)(Kw + key * 72 + d0) = w0; *(LAS u32x4*)(Kw + key * 72 + d0 + 8) = w1;
#pragma unroll
            for (int u = 0; u < 4; ++u)
#pragma unroll
                for (int e = 0; e < 4; ++e) Vw[(d0 + u * 4 + e) * 68 + key] = f2bf(vr[bufi][u][e]);
        };
        ld(0, 0); ld(1, 1); st(0, 0); ld(2, 0); st(1, 1); ld(3, 1); st(2, 0); st(3, 1);
    };
    int nlist = 0;
    {
        unsigned long long rem = anymask & 0x1FFFFFFFFull;
        while (rem) {
            const int j = __builtin_ctzll(rem); rem &= rem - 1ull;
            if ((nlist & 7) == wv) {
                stage_tile(false, j);
                const bool en = (mymask >> j) & 1ull;
                const unsigned vm0 = en ? (j < 32 ? 0xffffu : range_mask(j * 64, h, -1, pos)) : 0u, vm1 = en ? (j < 32 ? 0xffffu : range_mask(j * 64 + 32, h, -1, pos)) : 0u;
                attn_tile(Kw, Vw, Qf, os, vm0, vm1, r, h);
            }
            ++nlist;
        }
    }
    for (int wt = 0; wt < 9; ++wt, ++nlist) {
        if ((nlist & 7) == wv) {
            stage_tile(true, wt);
            const bool inner = (wt > 0 && wt < 8);
            const unsigned vm0 = inner ? 0xffffu : range_mask(wt * 64, h, tq + 1, 512 + tq), vm1 = inner ? 0xffffu : range_mask(wt * 64 + 32, h, tq + 1, 512 + tq);
            attn_tile(Kw, Vw, Qf, ow, vm0, vm1, r, h);
        }
    }
    __syncthreads();
    LAS float* part = (LAS float*)lds;
    {
        LAS float* ps = part + (size_t)(0 * 8 + wv) * 34 * 64 + lane; LAS float* pw = part + (size_t)(1 * 8 + wv) * 34 * 64 + lane;
#pragma unroll
        for (int reg = 0; reg < 16; ++reg) { ps[reg * 64] = os.o0[reg]; ps[(16 + reg) * 64] = os.o1[reg]; pw[reg * 64] = ow.o0[reg]; pw[(16 + reg) * 64] = ow.o1[reg]; }
        ps[32 * 64] = os.m; ps[33 * 64] = os.l; pw[32 * 64] = ow.m; pw[33 * 64] = ow.l;
    }
    __syncthreads();
    if (act) {
        f32x16 f0 = oc.o0 * gt0, f1 = oc.o1 * gt0;
#pragma unroll
        for (int stt = 0; stt < 2; ++stt) {
            LAS const float* pb = part + (size_t)(stt * 8) * 34 * 64 + lane;
            float M = -1e30f;
#pragma unroll
            for (int w = 0; w < 8; ++w) M = fmaxf(M, pb[(size_t)w * 34 * 64 + 32 * 64]);
            float L = 0.f; f32x16 a0, a1;
#pragma unroll
            for (int reg = 0; reg < 16; ++reg) { a0[reg] = 0.f; a1[reg] = 0.f; }
#pragma unroll
            for (int w = 0; w < 8; ++w) {
                LAS const float* pq = pb + (size_t)w * 34 * 64; const float sc = __builtin_amdgcn_exp2f(pq[32 * 64] - M);
                L += pq[33 * 64] * sc;
#pragma unroll
                for (int reg = 0; reg < 16; ++reg) { a0[reg] += pq[reg * 64] * sc; a1[reg] += pq[(16 + reg) * 64] * sc; }
            }
            const float Lt = L + __shfl_xor(L, 32); const float gs = (Lt > 0.f) ? (stt == 0 ? gt1 : gt2) / Lt : 0.f;
            f0 = f0 + a0 * gs; f1 = f1 + a1 * gs;
        }
        attn_store(p, m, head, f0, f1, h);
    }
}

__device__ __forceinline__ void phase3(LAS unsigned char* lds, int bid, int nb) {
    CParams& p = kparams();
    LAS unsigned* slot = (LAS unsigned*)(lds + LDS_BYTES - 64);
    unsigned* ctr = (unsigned*)(p.ws + W_BAR + 3456 * 4);
    for (;;) {
        __syncthreads();
        if (threadIdx.x == 0) *slot = atomicAdd(ctr, 1u);
        __syncthreads();
        const int item = __builtin_amdgcn_readfirstlane((int)*slot);
        if (item >= 32 + 512 + 256 + 512) break;
        if (item < 32) scan_chain(p, lds, item);
        else if (item < 800) {
            const int idx = item - 32;
            if (idx >= 384 && idx < 640) attn_sample_unit(p, lds, idx - 384); else attn_prompt_tile(p, lds, idx < 384 ? idx : idx - 256);
        }
        else scan_sample4(p, lds, item - 800);
    }
}

struct EpiG3 {
    static constexpr bool AFTER_DRAIN = false, HAS_MID = true; static constexpr int MID_T = 8;
    unsigned char* ws;
    __device__ __forceinline__ void mid(f32x4 (&acc)[2][2][4][2], const Unit& u, int wr, int wc, int fr, int fq) const {
#pragma unroll
        for (int ai = 0; ai < 2; ++ai)
#pragma unroll
            for (int m = 0; m < 4; ++m) { const size_t row = (size_t)u.pm * 256 + ai * 128 + wr * 64 + m * 16 + fr; const bf16_t* gp = (const bf16_t*)(ws + W_GATES) + row * 2048;
#pragma unroll
                for (int bj = 0; bj < 2; ++bj)
#pragma unroll
                    for (int n = 0; n < 2; ++n) { const int col = u.pn * 256 + bj * 128 + wc * 32 + n * 16 + fq * 4; acc[ai][bj][m][n] = acc[ai][bj][m][n] * ld_bf4(gp + col); } }
    }
    __device__ __forceinline__ void operator()(const f32x4 (&acc)[2][2][4][2], const Unit& u, int wr, int wc, int fr, int fq) const {
        u32x2 gv[2][4][2][2];
#pragma unroll
        for (int ai = 0; ai < 2; ++ai)
#pragma unroll
            for (int m = 0; m < 4; ++m) { const size_t row = (size_t)u.pm * 256 + ai * 128 + wr * 64 + m * 16 + fr; const bf16_t* gp = (const bf16_t*)(ws + W_GATES) + row * 2048;
#pragma unroll
                for (int bj = 0; bj < 2; ++bj)
#pragma unroll
                    for (int n = 0; n < 2; ++n) { const int col = u.pn * 256 + bj * 128 + wc * 32 + n * 16 + fq * 4; gv[ai][m][bj][n] = *(const u32x2*)(gp + 1024 + col); } }
#pragma unroll
        for (int ai = 0; ai < 2; ++ai)
#pragma unroll
            for (int m = 0; m < 4; ++m) { const size_t row = (size_t)u.pm * 256 + ai * 128 + wr * 64 + m * 16 + fr;
#pragma unroll
                for (int bj = 0; bj < 2; ++bj)
#pragma unroll
                    for (int n = 0; n < 2; ++n) { const int col = u.pn * 256 + bj * 128 + wc * 32 + n * 16 + fq * 4; const u32x2 g = gv[ai][m][bj][n];
                        *(u32x2*)((bf16_t*)(ws + W_MERGED) + row * 1024 + col) = pack4(acc[ai][bj][m][n] * (f32x4){bf_lo(g.x), bf_hi(g.x), bf_lo(g.y), bf_hi(g.y)}); } }
    }
};
struct EpiG4 {
    static constexpr bool AFTER_DRAIN = false, HAS_MID = false; static constexpr int MID_T = 0;
    unsigned char* ws; const float* xp; const float* xs;
    __device__ __forceinline__ void mid(f32x4 (&)[2][2][4][2], const Unit&, int, int, int, int) const {}
    __device__ __forceinline__ void operator()(const f32x4 (&acc)[2][2][4][2], const Unit& u, int wr, int wc, int fr, int fq) const {
#pragma unroll
        for (int ai = 0; ai < 2; ++ai) {
            f32x4 xv[4][2][2];
#pragma unroll
            for (int m = 0; m < 4; ++m) { const size_t row = (size_t)u.pm * 256 + ai * 128 + wr * 64 + m * 16 + fr; const float* xr = row < NPT ? xp + row * 1024 : xs + (row - NPT) * 1024;
#pragma unroll
                for (int bj = 0; bj < 2; ++bj)
#pragma unroll
                    for (int n = 0; n < 2; ++n) xv[m][bj][n] = *(const f32x4*)(xr + u.pn * 256 + bj * 128 + wc * 32 + n * 16 + fq * 4); }
            __builtin_amdgcn_sched_barrier(0);
#pragma unroll
            for (int m = 0; m < 4; ++m) { const size_t row = (size_t)u.pm * 256 + ai * 128 + wr * 64 + m * 16 + fr; float ss = 0.f;
#pragma unroll
                for (int bj = 0; bj < 2; ++bj) { u32x2 pk[2];
#pragma unroll
                    for (int n = 0; n < 2; ++n) {
                        const f32x4 x2 = xv[m][bj][n] + acc[ai][bj][m][n];
                        ss += x2[0] * x2[0] + x2[1] * x2[1] + x2[2] * x2[2] + x2[3] * x2[3];
                        pk[n] = pack4(x2); }
                    *(u32x4*)((bf16_t*)(ws + W_X2) + row * 1024 + u.pn * 256 + bj * 128 + wc * 32 + col8_of(fq)) = widen16(pk[0], pk[1]); }
                ss += __shfl_xor(ss, 16); ss += __shfl_xor(ss, 32);
                if (fq == 0) atomicAdd((float*)(ws + W_RS1) + row, ss); }
            __builtin_amdgcn_sched_barrier(0);
        }
    }
};
struct EpiG5 {
    static constexpr bool AFTER_DRAIN = false, HAS_MID = false; static constexpr int MID_T = 0;
    unsigned char* ws;
    __device__ __forceinline__ void mid(f32x4 (&)[2][2][4][2], const Unit&, int, int, int, int) const {}
    __device__ __forceinline__ void operator()(const f32x4 (&acc)[2][2][4][2], const Unit& u, int wr, int wc, int fr, int fq) const {
        float rsv[2][4];
#pragma unroll
        for (int ai = 0; ai < 2; ++ai)
#pragma unroll
            for (int m = 0; m < 4; ++m) rsv[ai][m] = ((const float*)(ws + W_RS1))[(size_t)u.pm * 256 + ai * 128 + wr * 64 + m * 16 + fr];
        __builtin_amdgcn_sched_barrier(0);
#pragma unroll
        for (int ai = 0; ai < 2; ++ai)
#pragma unroll
            for (int m = 0; m < 4; ++m) { const size_t row = (size_t)u.pm * 256 + ai * 128 + wr * 64 + m * 16 + fr;
                const float rs = rsqrtf(rsv[ai][m] * (1.0f / 1024.0f) + 1e-6f);
                u32x2 pk[2];
#pragma unroll
                for (int n = 0; n < 2; ++n) { f32x4 a;
#pragma unroll
                    for (int j = 0; j < 4; ++j) { const float gt = acc[ai][0][m][n][j] * rs, up = acc[ai][1][m][n][j] * rs; a[j] = gt * sigmoidf_(gt) * up; }
                    pk[n] = pack4(a); }
                *(u32x4*)((bf16_t*)(ws + W_ACT) + row * 2816 + u.pn * 128 + wc * 32 + col8_of(fq)) = widen16(pk[0], pk[1]); }
    }
};
struct EpiG6 {
    static constexpr bool AFTER_DRAIN = false, HAS_MID = false; static constexpr int MID_T = 0;
    unsigned char* ws;
    __device__ __forceinline__ void mid(f32x4 (&)[2][2][4][2], const Unit&, int, int, int, int) const {}
    __device__ __forceinline__ void operator()(const f32x4 (&acc)[2][2][4][2], const Unit& u, int wr, int wc, int fr, int fq) const {
#pragma unroll
        for (int ai = 0; ai < 2; ++ai) {
            u32x2 xv[4][2][2];
#pragma unroll
            for (int m = 0; m < 4; ++m) { const size_t row = (size_t)u.pm * 256 + ai * 128 + wr * 64 + m * 16 + fr;
#pragma unroll
                for (int bj = 0; bj < 2; ++bj)
#pragma unroll
                    for (int n = 0; n < 2; ++n) xv[m][bj][n] = *(const u32x2*)((const bf16_t*)(ws + W_X2) + row * 1024 + u.pn * 256 + bj * 128 + wc * 32 + n * 16 + fq * 4); }
            __builtin_amdgcn_sched_barrier(0);
#pragma unroll
            for (int m = 0; m < 4; ++m) { const size_t row = (size_t)u.pm * 256 + ai * 128 + wr * 64 + m * 16 + fr; float ss = 0.f;
#pragma unroll
                for (int bj = 0; bj < 2; ++bj) { u32x2 pk[2];
#pragma unroll
                    for (int n = 0; n < 2; ++n) { const u32x2 xg = xv[m][bj][n];
                        const f32x4 x3 = (f32x4){bf_lo(xg.x), bf_hi(xg.x), bf_lo(xg.y), bf_hi(xg.y)} + acc[ai][bj][m][n];
                        ss += x3[0] * x3[0] + x3[1] * x3[1] + x3[2] * x3[2] + x3[3] * x3[3];
                        pk[n] = pack4(x3); }
                    *(u32x4*)((bf16_t*)(ws + W_X3) + row * 1024 + u.pn * 256 + bj * 128 + wc * 32 + col8_of(fq)) = widen16(pk[0], pk[1]); }
                ss += __shfl_xor(ss, 16); ss += __shfl_xor(ss, 32);
                if (fq == 0) atomicAdd((float*)(ws + W_RS2) + row, ss); }
            __builtin_amdgcn_sched_barrier(0);
        }
    }
};
constexpr int ST_PITCH = 264, ST_MAT = 64 * ST_PITCH * 2, ST_BUF = 2 * ST_MAT;
template <int KIND> __device__ __forceinline__ void small_tile(CParams& p, LAS unsigned char* lds, int tile) {
    unsigned char* ws = p.ws;
    const int tid = opaque_tid(), w = tid >> 6, lane = tid & 63, fr = lane & 15, fq = lane >> 4;
    const int xs = tile & 7, is = tile >> 3;
    const int rt = (xs >> 1) * 4 + (is & 3), ct = (xs & 1) * 8 + (is >> 2);
    const int row = NPT + rt * 64 + 16 * (w >> 1) + fr, ncol0 = ct * 64 + 32 * (w & 1);
    const int K = KIND == 2 ? 2816 : 1024;
    const bf16_t* Ag = (const bf16_t*)(ws + (KIND == 0 ? W_YCAT : (KIND == 1 ? W_MERGED : W_ACT))) + (size_t)(NPT + rt * 64) * K;
    const bf16_t* Bg = (const bf16_t*)(ws + (KIND == 0 ? W_BTM : (KIND == 1 ? W_BTO : W_BTD))) + (size_t)(ct * 64) * K;
    f32x4 acc[2] = {(f32x4){0.f, 0.f, 0.f, 0.f}, (f32x4){0.f, 0.f, 0.f, 0.f}};
    u32x4 ra[4], rb[4];
    auto gld = [&](int kc) {
#pragma unroll
        for (int q = 0; q < 4; ++q) { const int idx = tid + 512 * q, r2 = idx >> 5, c = idx & 31;
            ra[q] = *(const u32x4*)(Ag + (size_t)r2 * K + kc + c * 8); rb[q] = *(const u32x4*)(Bg + (size_t)r2 * K + kc + c * 8); }
    };
    auto lst = [&](int bi) {
#pragma unroll
        for (int q = 0; q < 4; ++q) { const int idx = tid + 512 * q, r2 = idx >> 5, c = idx & 31;
            *(LAS u32x4*)(lds + bi * ST_BUF + (r2 * ST_PITCH + c * 8) * 2) = ra[q]; *(LAS u32x4*)(lds + bi * ST_BUF + ST_MAT + (r2 * ST_PITCH + c * 8) * 2) = rb[q]; }
    };
    const int nchunk = K / 256;
    const bf16_t* gp = (const bf16_t*)(ws + W_GATES) + (size_t)row * 2048;
    __syncthreads();
    gld(0);
    for (int ci = 0; ci < nchunk; ++ci) {
        lst(ci & 1);
        __syncthreads();
        if (ci + 1 < nchunk) gld((ci + 1) * 256);
        if (KIND == 0 && ci == 2) {
#pragma unroll
            for (int u = 0; u < 2; ++u) acc[u] = acc[u] * ld_bf4(gp + ncol0 + 16 * u + 4 * fq);
        }
        LAS const bf16_t* Al = (LAS const bf16_t*)(lds + (ci & 1) * ST_BUF) + (16 * (w >> 1) + fr) * ST_PITCH + 8 * fq;
        LAS const bf16_t* Bl = (LAS const bf16_t*)(lds + (ci & 1) * ST_BUF + ST_MAT) + (32 * (w & 1) + fr) * ST_PITCH + 8 * fq;
#pragma unroll
        for (int s = 0; s < 8; ++s) {
            const bf16x8 a = *(const LAS bf16x8*)(Al + 32 * s), w0 = *(const LAS bf16x8*)(Bl + 32 * s), w1 = *(const LAS bf16x8*)(Bl + 16 * ST_PITCH + 32 * s);
            acc[0] = mfma16(w0, a, acc[0]); acc[1] = mfma16(w1, a, acc[1]);
        }
    }
    if (KIND == 0) {
#pragma unroll
        for (int u = 0; u < 2; ++u) { const int col = ncol0 + 16 * u + 4 * fq; *(u32x2*)((bf16_t*)(ws + W_MERGED) + (size_t)row * 1024 + col) = pack4(acc[u] * ld_bf4(gp + 1024 + col)); }
    } else if (KIND == 1) {
        const float* xr = p.in[1] + (size_t)(row - NPT) * 1024; float ss = 0.f;
#pragma unroll
        for (int u = 0; u < 2; ++u) { const int col = ncol0 + 16 * u + 4 * fq;
            const f32x4 x2 = *(const f32x4*)(xr + col) + acc[u];
            ss += x2[0] * x2[0] + x2[1] * x2[1] + x2[2] * x2[2] + x2[3] * x2[3];
            *(u32x2*)((bf16_t*)(ws + W_X2) + (size_t)row * 1024 + col) = pack4(x2); }
        ss += __shfl_xor(ss, 16); ss += __shfl_xor(ss, 32);
        if (fq == 0) atomicAdd((float*)(ws + W_RS1) + row, ss);
    } else {
        float ss = 0.f;
#pragma unroll
        for (int u = 0; u < 2; ++u) { const int col = ncol0 + 16 * u + 4 * fq;
            const f32x4 x3 = ld_bf4((const bf16_t*)(ws + W_X2) + (size_t)row * 1024 + col) + acc[u];
            ss += x3[0] * x3[0] + x3[1] * x3[1] + x3[2] * x3[2] + x3[3] * x3[3];
            *(u32x2*)((bf16_t*)(ws + W_X3) + (size_t)row * 1024 + col) = pack4(x3); }
        ss += __shfl_xor(ss, 16); ss += __shfl_xor(ss, 32);
        if (fq == 0) atomicAdd((float*)(ws + W_RS2) + row, ss);
    }
}
__device__ __forceinline__ void phase_gn(int bid, int nb) {
    CParams& p = kparams();
    unsigned char* ws = p.ws;
    const int tid4 = opaque_tid(); const int lane = tid4 & 63; const int gw = bid * 8 + (tid4 >> 6), nw = nb * 8;
    const int c0 = lane * 8, hd = lane >> 3;
    const f32x4 lw0 = *(const f32x4*)(p.in[19] + c0), lw1 = *(const f32x4*)(p.in[19] + c0 + 4), lb0 = *(const f32x4*)(p.in[20] + c0), lb1 = *(const f32x4*)(p.in[20] + c0 + 4);
#pragma unroll 1
    for (int m0 = gw; m0 < NTOK; m0 += 4 * nw) {
      f32x4 ya[4], yb[4]; u32x4 vr[4], gr[4]; float bn[4];
#pragma unroll
      for (int q = 0; q < 4; ++q) { const int mm = min(m0 + q * nw, NTOK - 1);
          const float* y = (const float*)(ws + W_YRAW) + (size_t)mm * 512 + c0; ya[q] = *(const f32x4*)y; yb[q] = *(const f32x4*)(y + 4);
          bn[q] = ((const float*)(ws + W_BON))[(size_t)mm * 8 + hd];
          vr[q] = *(const u32x4*)((const bf16_t*)(ws + W_V) + (size_t)mm * 512 + c0); gr[q] = *(const u32x4*)((const bf16_t*)(ws + W_G) + (size_t)mm * 512 + c0); }
#pragma unroll
      for (int q = 0; q < 4; ++q) { const int m = m0 + q * nw; if (m < NTOK) {
        const f32x4 y0 = ya[q], y1 = yb[q];
        const float mean = allreduce8((y0[0] + y0[1]) + (y0[2] + y0[3]) + (y1[0] + y1[1]) + (y1[2] + y1[3])) * (1.0f / 64.0f);
        const f32x4 e0 = y0 - mean, e1 = y1 - mean;
        const float var = allreduce8((e0[0] * e0[0] + e0[1] * e0[1]) + (e0[2] * e0[2] + e0[3] * e0[3]) + (e1[0] * e1[0] + e1[1] * e1[1]) + (e1[2] * e1[2] + e1[3] * e1[3])) * (1.0f / 64.0f);
        const float rstd = rsqrtf(var + 64e-5f);
        const float bon = bn[q]; const u32x4 vq = vr[q], gq = gr[q];
        const f32x4 v0 = (f32x4){bf_lo(vq.x), bf_hi(vq.x), bf_lo(vq.y), bf_hi(vq.y)}, v1 = (f32x4){bf_lo(vq.z), bf_hi(vq.z), bf_lo(vq.w), bf_hi(vq.w)};
        const f32x4 g0 = (f32x4){bf_lo(gq.x), bf_hi(gq.x), bf_lo(gq.y), bf_hi(gq.y)}, g1 = (f32x4){bf_lo(gq.z), bf_hi(gq.z), bf_lo(gq.w), bf_hi(gq.w)};
        const f32x4 o0 = (e0 * rstd * lw0 + lb0 + v0 * bon) * g0, o1 = (e1 * rstd * lw1 + lb1 + v1 * bon) * g1;
        u32x4 w; w.x = cvt_pk_bf16(o0[0], o0[1]); w.y = cvt_pk_bf16(o0[2], o0[3]); w.z = cvt_pk_bf16(o1[0], o1[1]); w.w = cvt_pk_bf16(o1[2], o1[3]);
        *(u32x4*)((bf16_t*)(ws + W_YCAT) + (size_t)m * 1024 + c0) = w;
      } }
    }
}
__device__ __forceinline__ void phase4(LAS unsigned char* lds, int bid, int nb) {
    CParams& p = kparams();
    pg8::Gemm g{(const bf16_t*)(p.ws + W_YCAT), (const bf16_t*)(p.ws + W_BTM), NPT, 1024, 1024};
    const int sfirst = (bid >> 3) & 1;
    if (sfirst) { for (int tile = bid; tile < 256; tile += nb) small_tile<0>(p, lds, tile); }
    { pg8::StaticOrder S; S.init(NPT, 1024, nb, bid); EpiG3 E{p.ws}; pg8::gemm_phase(lds, g, S, E); }
    if (!sfirst) { for (int tile = bid; tile < 256; tile += nb) small_tile<0>(kparams(), lds, tile); }
}
__device__ __forceinline__ void phase5(LAS unsigned char* lds, int bid, int nb) {
    CParams& p = kparams();
    pg8::Gemm g{(const bf16_t*)(p.ws + W_MERGED), (const bf16_t*)(p.ws + W_BTO), NPT, 1024, 1024};
    const int sfirst = (bid >> 3) & 1;
    if (sfirst) { for (int tile = bid; tile < 256; tile += nb) small_tile<1>(p, lds, tile); }
    { pg8::StaticOrder S; S.init(NPT, 1024, nb, bid); EpiG4 E{p.ws, p.in[0], p.in[1]}; pg8::gemm_phase(lds, g, S, E); }
    if (!sfirst) { for (int tile = bid; tile < 256; tile += nb) small_tile<1>(kparams(), lds, tile); }
}
__device__ __forceinline__ void phase6(LAS unsigned char* lds, int bid, int nb) {
    CParams& p = kparams();
    pg8::Gemm g{(const bf16_t*)(p.ws + W_X2), (const bf16_t*)(p.ws + W_BTGU), NTOK, 5632, 1024};
    pg8::StaticOrder S; S.init(NTOK, 5632, nb, bid); EpiG5 E{p.ws}; pg8::gemm_phase(lds, g, S, E);
}
__device__ __forceinline__ void phase7(LAS unsigned char* lds, int bid, int nb) {
    CParams& p = kparams();
    pg8::Gemm g{(const bf16_t*)(p.ws + W_ACT), (const bf16_t*)(p.ws + W_BTD), NPT, 1024, 2816};
    const int sfirst = (bid >> 3) & 1;
    if (sfirst) { for (int tile = bid; tile < 256; tile += nb) small_tile<2>(p, lds, tile); }
    { pg8::StaticOrder S; S.init(NPT, 1024, nb, bid); EpiG6 E{p.ws}; pg8::gemm_phase(lds, g, S, E); }
    if (!sfirst) { for (int tile = bid; tile < 256; tile += nb) small_tile<2>(kparams(), lds, tile); }
}
__device__ __forceinline__ void phase8(int bid, int nb) {
    CParams& p = kparams();
    const size_t gtid = (size_t)bid * NTHR + opaque_tid(), gsz = (size_t)nb * NTHR;
    const bf16_t* x3 = (const bf16_t*)(p.ws + W_X3); const float* rs2 = (const float*)(p.ws + W_RS2); const float* gf = p.in[31];
    const int c8 = (int)(gtid & 127) * 8; const f32x4 g0 = *(const f32x4*)(gf + c8), g1 = *(const f32x4*)(gf + c8 + 4);
    const unsigned total = (unsigned)NTOK * 128u, st = (unsigned)gsz;
#pragma unroll 1
    for (unsigned i0 = (unsigned)gtid; i0 < total; i0 += 4u * st) {
        u32x4 xr[4]; float rr[4];
#pragma unroll
        for (int q = 0; q < 4; ++q) { const unsigned ii = min(i0 + (unsigned)q * st, total - 128u + (unsigned)(gtid & 127)); const unsigned row = ii >> 7; rr[q] = rs2[row]; xr[q] = *(const u32x4*)(x3 + (size_t)row * 1024 + c8); }
#pragma unroll
        for (int q = 0; q < 4; ++q) { const unsigned i = i0 + (unsigned)q * st; if (i < total) { const size_t row = i >> 7;
            const float rs = rsqrtf(rr[q] * (1.0f / 1024.0f) + 1e-6f); const u32x4 x = xr[q];
            *(f32x4*)(p.out + row * 1024 + c8) = (f32x4){bf_lo(x.x), bf_hi(x.x), bf_lo(x.y), bf_hi(x.y)} * rs * g0;
            *(f32x4*)(p.out + row * 1024 + c8 + 4) = (f32x4){bf_lo(x.z), bf_hi(x.z), bf_lo(x.w), bf_hi(x.w)} * rs * g1; } }
    }
}

#define XB_TMO      128
#define XB_XCNT(j)  (256  + 64 * (j))
#define XB_XSUB(j)  (1280 + 64 * (j))
#define XB_XGEN(j)  (2304 + 64 * (j))
#define XB_TOP      3328
#define XB_TOPGEN   3392
#define XB_SPIN_CAP (1u << 22)
__device__ __forceinline__ unsigned xb_ld(unsigned* p)              { return __hip_atomic_load(p, __ATOMIC_RELAXED, __HIP_MEMORY_SCOPE_AGENT); }
__device__ __forceinline__ unsigned xb_add(unsigned* p, unsigned v) { return __hip_atomic_fetch_add(p, v, __ATOMIC_RELAXED, __HIP_MEMORY_SCOPE_AGENT); }
__device__ __forceinline__ unsigned xb_xcc_id() { return (unsigned)__builtin_amdgcn_s_getreg((3 << 11) | 20) & 0xFu; }
#define XB_SPIN(cond, bar) do { unsigned _sp = 0; while (cond) { __builtin_amdgcn_s_sleep(1); \
    if ((++_sp & 255u) == 0u) { if (xb_ld(&(bar)[XB_TMO])) break; if (_sp > XB_SPIN_CAP) { atomicAdd(&(bar)[XB_TMO], 1u); break; } } } } while (0)
struct XcdBarrier { unsigned* bar; unsigned x; volatile LAS unsigned* st; };
__device__ __forceinline__ XcdBarrier xcd_barrier_post(unsigned* bar, volatile LAS unsigned* st) {
    XcdBarrier b; b.bar = bar; b.x = xb_xcc_id(); b.st = st;
    if (threadIdx.x == 0) (void)xb_add(&bar[XB_XCNT(b.x)], 1u);
    return b;
}
__device__ __forceinline__ void xcd_barrier_complete(unsigned* bar, unsigned x, unsigned& nloc, unsigned& nx) {
    const unsigned G = gridDim.x * gridDim.y * gridDim.z;
    unsigned sum, cnt, mine, sp = 0u;
    for (;;) {
        sum = 0u; cnt = 0u; mine = 0u;
#pragma unroll
        for (unsigned j = 0; j < 16; ++j) { const unsigned c = xb_ld(&bar[XB_XCNT(j)]); sum += c; cnt += (c > 0u) ? 1u : 0u; mine = (j == x) ? c : mine; }
        if (sum == G) break;
        __builtin_amdgcn_s_sleep(1);
        if ((++sp & 255u) == 0u) { if (xb_ld(&bar[XB_TMO])) break; if (sp > XB_SPIN_CAP) { atomicAdd(&bar[XB_TMO], 1u); break; } }
    }
    nloc = mine > 0u ? mine : 1u; nx = cnt > 0u ? cnt : 1u;
}
__device__ __forceinline__ void xcd_barrier(const XcdBarrier& b) {
    asm volatile("s_waitcnt vmcnt(0)" ::: "memory");
    __syncthreads();
    if (threadIdx.x == 0) {
        unsigned* bar = b.bar;
        __builtin_amdgcn_s_waitcnt(0);
        unsigned nloc = b.st[0], nx = b.st[1];
        if (nloc == 0u) { xcd_barrier_complete(bar, b.x, nloc, nx); b.st[0] = nloc; b.st[1] = nx; }
        const unsigned old = xb_add(&bar[XB_XSUB(b.x)], 1u);
        const unsigned gen = old / nloc;
        if (old + 1u == (gen + 1u) * nloc) {
            __builtin_amdgcn_fence(__ATOMIC_RELEASE, "agent");
            asm volatile("s_waitcnt vmcnt(0)" ::: "memory");
            const unsigned og = xb_add(&bar[XB_TOP], 1u);
            const unsigned tg = og / nx;
            if (og + 1u == (tg + 1u) * nx) xb_add(&bar[XB_TOPGEN], 1u);
            else XB_SPIN(xb_ld(&bar[XB_TOPGEN]) == tg, bar);
            __builtin_amdgcn_fence(__ATOMIC_ACQUIRE, "agent");
            xb_add(&bar[XB_XGEN(b.x)], 1u);
            asm volatile("s_waitcnt vmcnt(0)" ::: "memory");
        } else {
            XB_SPIN(xb_ld(&bar[XB_XGEN(b.x)]) == gen, bar);
            __builtin_amdgcn_fence(__ATOMIC_ACQUIRE, "agent");
            asm volatile("s_waitcnt vmcnt(0)" ::: "memory");
        }
    }
    __syncthreads();
}

extern __shared__ __attribute__((aligned(16))) unsigned char smem_raw[];

__global__ __launch_bounds__(512) void fwd_kernel(Params p) {
    cg::grid_group grid = cg::this_grid();
    LAS unsigned char* lds = (LAS unsigned char*)smem_raw;
    const int bid = blockIdx.x, nb = gridDim.x;
    if (p.ph_lo < 0) grid.sync();
    volatile LAS unsigned* bst = (volatile LAS unsigned*)(lds + LDS_BYTES - 32);
    if (threadIdx.x == 0) { bst[0] = 0u; bst[1] = 0u; }
    __syncthreads();
    const XcdBarrier xb = xcd_barrier_post((unsigned*)(p.ws + W_BAR), bst);
#define RUN_PHASE(k, call) { if ((k) > 0) xcd_barrier(xb); call; }
    RUN_PHASE(0, phase0(bid, nb));
    RUN_PHASE(1, phase1(lds, bid, nb));
    RUN_PHASE(2, phase2(lds, bid, nb));
    RUN_PHASE(3, phase3(lds, bid, nb));
    RUN_PHASE(4, phase_gn(bid, nb));
    RUN_PHASE(5, phase4(lds, bid, nb));
    RUN_PHASE(6, phase5(lds, bid, nb));
    RUN_PHASE(7, phase6(lds, bid, nb));
    RUN_PHASE(8, phase7(lds, bid, nb));
    RUN_PHASE(9, phase8(bid, nb));
#undef RUN_PHASE
}

extern "C" void kernel_launch(void* const* d_in, const int* in_sizes, int n_in, void* d_out, int out_size, void* d_ws, size_t ws_size, hipStream_t stream) {
    static int grid_blocks = 0;
    if (!grid_blocks) {
        int dev = 0, cus = 0, per_cu = 0;
        (void)hipGetDevice(&dev);
        (void)hipDeviceGetAttribute(&cus, hipDeviceAttributeMultiprocessorCount, dev);
        (void)hipFuncSetAttribute((const void*)fwd_kernel, hipFuncAttributeMaxDynamicSharedMemorySize, LDS_BYTES);
        (void)hipOccupancyMaxActiveBlocksPerMultiprocessor(&per_cu, (const void*)fwd_kernel, NTHR, LDS_BYTES);
        if (per_cu != 1) fprintf(stderr, "note: occupancy query reports %d blocks per CU (expected 1)\n", per_cu);
        grid_blocks = cus;
        if (ws_size < W_END) fprintf(stderr, "workspace too small: %zu < %zu\n", ws_size, (size_t)W_END);
    }
    (void)hipMemsetAsync((unsigned char*)d_ws + W_BAR, 0, W_BAR_BYTES, stream);
    Params p{};
    for (int i = 0; i < 32; ++i) p.in[i] = (const float*)d_in[i];
    p.out = (float*)d_out; p.ws = (unsigned char*)d_ws; p.ph_lo = 0; p.ph_hi = 10;
    void* args[] = {&p};
    hipError_t e = hipLaunchCooperativeKernel((const void*)fwd_kernel, dim3(grid_blocks), dim3(NTHR), args, LDS_BYTES, stream);
    if (e != hipSuccess) fprintf(stderr, "cooperative launch failed: %s (grid %d)\n", hipGetErrorString(e), grid_blocks);
}
```
